# Optimizing an MI355X kernel written in HIP

```python
import math
import jax
import jax.numpy as jnp
from jax import lax
import numpy as np

D_MODEL = 2048
BATCH = 8
SEQ = 2048
DEPTH = 1

MIX_WIDTH = D_MODEL
ATTN_WIDTH = MIX_WIDTH // 2
ATTN_HEAD_DIM = 128
N_ATTN_HEADS = ATTN_WIDTH // ATTN_HEAD_DIM
RET_WIDTH = MIX_WIDTH - ATTN_WIDTH
RET_HEAD_DIM = 256
N_RET_HEADS = RET_WIDTH // RET_HEAD_DIM
RET_CHUNK = 128
DILATED_PATTERNS = ((128, 1), (512, 4), (2048, 16))
FFN_HIDDEN = ((8 * D_MODEL // 3 + 255) // 256) * 256
IN_PROJ_WIDTH = 3 * ATTN_WIDTH + 4 * RET_WIDTH
NORM_EPS = 1e-6

kernel_name = "hybrid_dilated_attn_retention_block"


def _rmsnorm(x, w):
    x32 = x.astype(jnp.float32)
    y = x32 * lax.rsqrt(jnp.mean(x32 * x32, axis=-1, keepdims=True) + NORM_EPS)
    return (y * w.astype(jnp.float32)).astype(x.dtype)


def _alibi_slopes(n_heads):
    return jnp.exp2(-8.0 * jnp.arange(1, n_heads + 1, dtype=jnp.float32) / n_heads)


def _dilated_branch(q, k, v, slopes, window, dilation):
    B, H, S, hd = q.shape
    blk = window // dilation
    span = dilation * blk
    sp = -(-S // span) * span
    L = sp // dilation
    nb = L // blk

    def to_sub(t):
        t = jnp.pad(t, ((0, 0), (0, 0), (0, sp - S), (0, 0)))
        t = t.reshape(B, H, L, dilation, hd).transpose(0, 1, 3, 2, 4)
        return t.reshape(B, H, dilation, nb, blk, hd)

    def two_block(t):
        prev = jnp.concatenate([jnp.zeros_like(t[:, :, :, :1]), t[:, :, :, :-1]], axis=3)
        return jnp.concatenate([prev, t], axis=4)

    qb = to_sub(q)
    kk = two_block(to_sub(k))
    vv = two_block(to_sub(v))
    s = jnp.einsum('bhrnqd,bhrnkd->bhrnqk', qb, kk).astype(jnp.float32) * (1.0 / math.sqrt(hd))
    qi = jnp.arange(blk)[:, None]
    kj = jnp.arange(2 * blk)[None, :]
    diff = qi - kj + blk
    key_idx = jnp.arange(nb)[:, None, None] * blk + kj[None] - blk
    valid = (diff >= 0) & (diff <= blk) & (key_idx >= 0)
    bias = -slopes[:, None, None] * (diff * dilation).astype(jnp.float32)
    s = s + bias[None, :, None, None]
    s = jnp.where(valid, s, -jnp.inf)
    lse = jax.nn.logsumexp(s, axis=-1)
    p = jnp.exp(s - lse[..., None])
    o = jnp.einsum('bhrnqk,bhrnkd->bhrnqd', p.astype(v.dtype), vv)

    def from_sub(t):
        tail = t.shape[5:]
        t = t.reshape((B, H, dilation, L) + tail)
        t = jnp.moveaxis(t, 2, 3)
        return t.reshape((B, H, sp) + tail)[:, :, :S]

    return from_sub(o), from_sub(lse)


def _dilated_attention(q, k, v):
    slopes = _alibi_slopes(q.shape[1])
    outs, lses = [], []
    for window, dilation in DILATED_PATTERNS:
        o, l = _dilated_branch(q, k, v, slopes, window, dilation)
        outs.append(o.astype(jnp.float32))
        lses.append(l)
    wts = jax.nn.softmax(jnp.stack(lses), axis=0)
    return jnp.sum(wts[..., None] * jnp.stack(outs), axis=0)


def _retention_chunkwise(q, k, v):
    B, H, S, dh = q.shape
    C = RET_CHUNK
    nc = S // C
    log_gamma = jnp.log(1.0 - jnp.exp2(-5.0 - jnp.arange(H, dtype=jnp.float32)))
    k = k * (1.0 / math.sqrt(dh))
    qc = q.reshape(B, H, nc, C, dh)
    kc = k.reshape(B, H, nc, C, dh)
    vc = v.reshape(B, H, nc, C, dh)
    idx = jnp.arange(C, dtype=jnp.float32)
    dif = idx[:, None] - idx[None, :]
    decay = jnp.where(dif >= 0, jnp.exp(log_gamma[:, None, None] * jnp.maximum(dif, 0.0)), 0.0)
    scores = jnp.einsum('bhnid,bhnjd->bhnij', qc, kc) * decay[None, :, None]
    inner = jnp.einsum('bhnij,bhnjd->bhnid', scores, vc)
    zeta = jnp.exp(log_gamma[:, None] * (C - 1.0 - idx))
    kv = jnp.einsum('bhnjd,bhnje->bhnde', kc * zeta[None, :, None, :, None], vc)
    gamma_chunk = jnp.exp(log_gamma * C)[None, :, None, None]

    def step(state, kv_n):
        return state * gamma_chunk + kv_n, state

    _, r_prev = lax.scan(step, jnp.zeros((B, H, dh, dh), jnp.float32), jnp.moveaxis(kv, 2, 0))
    r_prev = jnp.moveaxis(r_prev, 0, 2)
    xi = jnp.exp(log_gamma[:, None] * (idx + 1.0))
    cross = jnp.einsum('bhnid,bhnde->bhnie', qc, r_prev) * xi[None, :, None, :, None]
    return (inner + cross).reshape(B, H, S, dh)


def _heads(t, n_heads, head_dim):
    B, S, _ = t.shape
    return t.reshape(B, S, n_heads, head_dim).transpose(0, 2, 1, 3)


def _merge(t):
    B, H, S, hd = t.shape
    return t.transpose(0, 2, 1, 3).reshape(B, S, H * hd)


def _hybrid_mixer(h, w_in, w_out):
    proj = jnp.einsum('bsd,de->bse', h, w_in)
    cuts = np.cumsum([ATTN_WIDTH] * 3 + [RET_WIDTH] * 3)
    qa, ka, va, qr, kr, vr, gr = jnp.split(proj, cuts, axis=-1)
    attn = _dilated_attention(_heads(qa, N_ATTN_HEADS, ATTN_HEAD_DIM),
                              _heads(ka, N_ATTN_HEADS, ATTN_HEAD_DIM),
                              _heads(va, N_ATTN_HEADS, ATTN_HEAD_DIM))
    f32 = jnp.float32
    ret = _retention_chunkwise(_heads(qr, N_RET_HEADS, RET_HEAD_DIM).astype(f32),
                               _heads(kr, N_RET_HEADS, RET_HEAD_DIM).astype(f32),
                               _heads(vr, N_RET_HEADS, RET_HEAD_DIM).astype(f32))
    ret = ret * lax.rsqrt(jnp.mean(ret * ret, axis=-1, keepdims=True) + NORM_EPS)
    ret = jax.nn.silu(gr.astype(f32)) * _merge(ret)
    mixed = jnp.concatenate([_merge(attn), ret], axis=-1).astype(h.dtype)
    return jnp.einsum('bse,ed->bsd', mixed, w_out)


def _swiglu(h, w_gate, w_up, w_down):
    g = jnp.einsum('bsd,df->bsf', h, w_gate)
    u = jnp.einsum('bsd,df->bsf', h, w_up)
    return jnp.einsum('bsf,fd->bsd', jax.nn.silu(g) * u, w_down)


def setup_inputs(seed: int = 0) -> dict:
    key = jax.random.key(seed)
    ks = jax.random.split(key, 10)
    f32 = jnp.float32

    def normal(k, shape, fan_in):
        return jax.random.normal(k, shape, f32) * (fan_in ** -0.5)

    return {
        "x": jax.random.normal(ks[0], (BATCH, SEQ, D_MODEL), f32),
        "norm_mix_w": 1.0 + 0.02 * jax.random.normal(ks[1], (DEPTH, D_MODEL), f32),
        "w_in": normal(ks[2], (DEPTH, D_MODEL, IN_PROJ_WIDTH), D_MODEL),
        "w_out": normal(ks[3], (DEPTH, MIX_WIDTH, D_MODEL), MIX_WIDTH),
        "norm_ffn_w": 1.0 + 0.02 * jax.random.normal(ks[4], (DEPTH, D_MODEL), f32),
        "w_gate": normal(ks[5], (DEPTH, D_MODEL, FFN_HIDDEN), D_MODEL),
        "w_up": normal(ks[6], (DEPTH, D_MODEL, FFN_HIDDEN), D_MODEL),
        "w_down": normal(ks[7], (DEPTH, FFN_HIDDEN, D_MODEL), FFN_HIDDEN),
        "norm_final_w": 1.0 + 0.02 * jax.random.normal(ks[8], (D_MODEL,), f32),
    }


def reference(x, norm_mix_w, w_in, w_out, norm_ffn_w, w_gate, w_up, w_down, norm_final_w):
    for layer in range(DEPTH):
        h = _rmsnorm(x, norm_mix_w[layer])
        x = x + _hybrid_mixer(h, w_in[layer], w_out[layer])
        h = _rmsnorm(x, norm_ffn_w[layer])
        x = x + _swiglu(h, w_gate[layer], w_up[layer], w_down[layer])
    return _rmsnorm(x, norm_final_w)
```

```cpp
#include <hip/hip_runtime.h>
#include <hip/hip_cooperative_groups.h>
#include <cstdio>
#include <cstdint>
namespace cg = cooperative_groups;
namespace pg8 {
#define PG8_LAS __attribute__((address_space(3)))
typedef unsigned short bf16_t;
typedef short bf16x8 __attribute__((ext_vector_type(8)));
typedef float f32x4 __attribute__((ext_vector_type(4)));
typedef unsigned u32x4 __attribute__((ext_vector_type(4)));
constexpr int BM = 256, BK = 64, HALF = 128, HTB = HALF * BK * 2  , STAGE_BYTES = 8 * HTB, NXCD = 8, WGM = 4;

__host__ __device__ __forceinline__ int lds_byte(int r, int c) { const int st = (r >> 4) * 2 + (c >> 5), rr = r & 15, cc = c & 31, ob = rr * 64 + cc * 2; return st * 1024 + (ob ^ (((ob >> 9) & 1) << 5)); }
__host__ __device__ __forceinline__ void stage_rc(int b, int& R, int& C) { const int st = b / 1024, sb = b % 1024, swz = sb ^ (((sb >> 9) & 1) << 5); R = (st >> 1) * 16 + swz / 64; C = (st & 1) * 32 + (swz % 64) / 2; }
__host__ __device__ __forceinline__ int perm32(int rho) { const int n = rho >> 4, i = rho & 15; return 8 * (i >> 2) + 4 * n + (i & 3); }

struct Unit { int pm, pn; };
struct Gemm { const bf16_t* A; const bf16_t* Bt; int M, N, K; };

struct StaticOrder {
    int nM, nN, nwg, G, c;
    __host__ __device__ void init(int M, int N, int G_, int c_) { nM = M / BM; nN = N / BM; nwg = nM * nN; G = G_; c = c_; }
    __host__ __device__ bool next(int i, Unit& u) const {
        const long L = (long)i * G + c; if (L >= nwg) return false;
        int wgid = (int)L; { const int q = nwg / NXCD, r = nwg % NXCD, xcd = wgid % NXCD, off = wgid / NXCD; wgid = (xcd < r ? xcd * (q + 1) : r * (q + 1) + (xcd - r) * q) + off; }
        const int nig = WGM * nN, gid = wgid / nig, fm = gid * WGM, gsz = (nM - fm) < WGM ? (nM - fm) : WGM;
        u.pm = fm + ((wgid % nig) % gsz); u.pn = (wgid % nig) / gsz; return true;
    }
    __device__ __forceinline__ void a_ready(const Unit&) const {}
    __device__ __forceinline__ void done(const Unit&) const {}
};

__device__ __forceinline__ unsigned cvt_pk_bf16(float lo, float hi) { unsigned r; asm volatile("v_cvt_pk_bf16_f32 %0, %1, %2" : "=v"(r) : "v"(lo), "v"(hi)); return r; }
typedef unsigned u32x2 __attribute__((ext_vector_type(2)));

struct EpiProj {
    static constexpr bool PERM = true, AFTER_DRAIN = false;
    bf16_t* O; int ldc;
    __device__ __forceinline__ void operator()(const f32x4 (&acc)[2][2][4][2], const Unit& u, int wr, int wc, int fr, int fq) const {
        const int row0 = u.pm * BM + wr * 64 + fr, col0 = u.pn * BM + wc * 32 + 8 * fq;
        const int mode = (u.pn >= 12 && u.pn < 16) ? 1 : ((u.pn >= 16 && u.pn < 20) ? 2 : 0);
        float lg = 0.f; if (mode) { const int hd = (u.pn - 12) & 3; lg = __log2f(1.0f - __builtin_amdgcn_exp2f(-5.0f - (float)hd)); }
#pragma unroll
        for (int ai = 0; ai < 2; ++ai)
#pragma unroll
            for (int m = 0; m < 4; ++m) { const int row = row0 + ai * HALF + m * 16; bf16_t* rowp = O + (size_t)row * ldc + col0;
                float sc = 1.f;
                if (mode) { const float e = (float)((row & 2047) - 1024) * lg; sc = (mode == 1) ? __builtin_amdgcn_exp2f(e) : __builtin_amdgcn_exp2f(-e) * 0.0625f; }
#pragma unroll
                for (int bj = 0; bj < 2; ++bj) { const f32x4 v0 = acc[ai][bj][m][0] * sc, v1 = acc[ai][bj][m][1] * sc;
                    u32x4 w; w.x = cvt_pk_bf16(v0[0], v0[1]); w.y = cvt_pk_bf16(v0[2], v0[3]); w.z = cvt_pk_bf16(v1[0], v1[1]); w.w = cvt_pk_bf16(v1[2], v1[3]);
                    *(u32x4*)(rowp + bj * HALF) = w; } }
    }
};
template <bool BASE_BF16> struct EpiRes {
    static constexpr bool PERM = true, AFTER_DRAIN = false;
    const void* base; bf16_t* out; float* ss; int ldc;
    __device__ __forceinline__ void tail(const f32x4& b0, const f32x4& b1, const f32x4& a0, const f32x4& a1, bf16_t* dst, float& s) const {
        const f32x4 o0 = b0 + a0, o1 = b1 + a1;
        s += ((o0[0] * o0[0] + o0[1] * o0[1]) + (o0[2] * o0[2] + o0[3] * o0[3])) + ((o1[0] * o1[0] + o1[1] * o1[1]) + (o1[2] * o1[2] + o1[3] * o1[3]));
        u32x4 w; w.x = cvt_pk_bf16(o0[0], o0[1]); w.y = cvt_pk_bf16(o0[2], o0[3]); w.z = cvt_pk_bf16(o1[0], o1[1]); w.w = cvt_pk_bf16(o1[2], o1[3]);
        *(u32x4*)dst = w;
    }
    __device__ __forceinline__ void operator()(const f32x4 (&acc)[2][2][4][2], const Unit& u, int wr, int wc, int fr, int fq) const {
        const int col0 = u.pn * BM + wc * 32 + 8 * fq;
        if constexpr (BASE_BF16) {
            u32x4 raw[2][4][2];
#pragma unroll
            for (int ai = 0; ai < 2; ++ai)
#pragma unroll
                for (int m = 0; m < 4; ++m) { const int row = u.pm * BM + ai * HALF + wr * 64 + m * 16 + fr; const size_t off = (size_t)row * ldc + col0;
#pragma unroll
                    for (int bj = 0; bj < 2; ++bj) raw[ai][m][bj] = *(const u32x4*)((const bf16_t*)base + off + bj * HALF); }
            asm volatile("" ::: "memory");
#pragma unroll
            for (int ai = 0; ai < 2; ++ai)
#pragma unroll
                for (int m = 0; m < 4; ++m) { const int row = u.pm * BM + ai * HALF + wr * 64 + m * 16 + fr; const size_t off = (size_t)row * ldc + col0; float s = 0.f;
#pragma unroll
                    for (int bj = 0; bj < 2; ++bj) { const u32x4 r = raw[ai][m][bj];
                        const f32x4 b0 = {__uint_as_float(r.x << 16), __uint_as_float(r.x & 0xffff0000u), __uint_as_float(r.y << 16), __uint_as_float(r.y & 0xffff0000u)};
                        const f32x4 b1 = {__uint_as_float(r.z << 16), __uint_as_float(r.z & 0xffff0000u), __uint_as_float(r.w << 16), __uint_as_float(r.w & 0xffff0000u)};
                        tail(b0, b1, acc[ai][bj][m][0], acc[ai][bj][m][1], out + off + bj * HALF, s); }
                    s += __shfl_xor(s, 16); s += __shfl_xor(s, 32);
                    if (fq == 0) atomicAdd(ss + row, s); }
        } else {
#pragma unroll
            for (int ai = 0; ai < 2; ++ai) {
                f32x4 pb0[4][2], pb1[4][2];
#pragma unroll
                for (int m = 0; m < 4; ++m) { const int row = u.pm * BM + ai * HALF + wr * 64 + m * 16 + fr; const size_t off = (size_t)row * ldc + col0;
#pragma unroll
                    for (int bj = 0; bj < 2; ++bj) { const float* bp = (const float*)base + off + bj * HALF; pb0[m][bj] = *(const f32x4*)bp; pb1[m][bj] = *(const f32x4*)(bp + 4); } }
                asm volatile("" ::: "memory");
#pragma unroll
                for (int m = 0; m < 4; ++m) { const int row = u.pm * BM + ai * HALF + wr * 64 + m * 16 + fr; const size_t off = (size_t)row * ldc + col0; float s = 0.f;
#pragma unroll
                    for (int bj = 0; bj < 2; ++bj) tail(pb0[m][bj], pb1[m][bj], acc[ai][bj][m][0], acc[ai][bj][m][1], out + off + bj * HALF, s);
                    s += __shfl_xor(s, 16); s += __shfl_xor(s, 32);
                    if (fq == 0) atomicAdd(ss + row, s); }
                asm volatile("" ::: "memory");
            }
        }
    }
};
struct EpiGU {
    static constexpr bool PERM = true, AFTER_DRAIN = false;
    bf16_t* O; int ldc; const float* ss; float inv_n, eps;
    __device__ __forceinline__ void operator()(const f32x4 (&acc)[2][2][4][2], const Unit& u, int wr, int wc, int fr, int fq) const {
        const int row0 = u.pm * BM + wr * 64 + fr, col0 = u.pn * HALF + wc * 32 + 8 * fq;
        float rsv[2][4];
#pragma unroll
        for (int ai = 0; ai < 2; ++ai)
#pragma unroll
            for (int m = 0; m < 4; ++m) rsv[ai][m] = ss[row0 + ai * HALF + m * 16];
        asm volatile("" ::: "memory");
#pragma unroll
        for (int ai = 0; ai < 2; ++ai)
#pragma unroll
            for (int m = 0; m < 4; ++m) { const int row = row0 + ai * HALF + m * 16; const float rs = __builtin_amdgcn_rsqf(rsv[ai][m] * inv_n + eps);
                float a[8];
#pragma unroll
                for (int n = 0; n < 2; ++n)
#pragma unroll
                    for (int i = 0; i < 4; ++i) { const float g = acc[ai][0][m][n][i] * rs, up = acc[ai][1][m][n][i] * rs;
                        a[n * 4 + i] = g * __builtin_amdgcn_rcpf(1.0f + __builtin_amdgcn_exp2f(-1.4426950408889634f * g)) * up; }
                u32x4 w; w.x = cvt_pk_bf16(a[0], a[1]); w.y = cvt_pk_bf16(a[2], a[3]); w.z = cvt_pk_bf16(a[4], a[5]); w.w = cvt_pk_bf16(a[6], a[7]);
                *(u32x4*)(O + (size_t)row * ldc + col0) = w; }
    }
};

template <class Epi, class Sched, bool ALIGN_EPI = false, bool SP2 = false>
__device__ __forceinline__ void gemm_phase(PG8_LAS unsigned char* lds, const Gemm g, const Sched& S, const Epi& E) {
    int tid_ = threadIdx.x; asm volatile("" : "+v"(tid_));
    const int tid = tid_, wid = __builtin_amdgcn_readfirstlane(tid >> 6), lane = tid & 63, wr = wid >> 2, wc = wid & 3, fr = lane & 15, fq = lane >> 4;
    const int K = g.K, nt = K / BK;
    unsigned voffA[2], voffB[2];
#pragma unroll
    for (int i = 0; i < 2; ++i) { int R, C; stage_rc(tid * 16 + i * 8192, R, C); const int Rb = Epi::PERM ? ((R & ~31) + perm32(R & 31)) : R;
        voffA[i] = (unsigned)(R * K + C) * 2u; voffB[i] = (unsigned)(Rb * K + C) * 2u; }
    const size_t kstep = (size_t)(BK * 2);
    const size_t hstep = (size_t)HALF * K * 2;
    const size_t tstep = 2 * hstep;
    const unsigned ldsw = (unsigned)wid * 1024u;
    const int aoff = lds_byte(wr * 64 + fr, fq * 8), boff = lds_byte(wc * 32 + fr, fq * 8);
#define PG8_SA(b, h) (((b) * 2 + (h)) * HTB)
#define PG8_SB(b, h) ((4 + (b) * 2 + (h)) * HTB)
#define PG8_STAGE(bufoff, gbase, voff) do { _Pragma("unroll") for (int _i = 0; _i < 2; ++_i) \
        __builtin_amdgcn_global_load_lds((const unsigned*)((const char*)(gbase) + (voff)[_i]), (PG8_LAS unsigned*)(lds + (bufoff) + ldsw + _i * 8192), 16, 0, 0); } while (0)
#define PG8_LDA(dst, b, h) do { _Pragma("unroll") for (int m = 0; m < 4; ++m) _Pragma("unroll") for (int k = 0; k < 2; ++k) dst[m][k] = *(const PG8_LAS bf16x8*)(lds + PG8_SA(b, h) + aoff + m * 2048 + k * 1024); } while (0)
#define PG8_LDB(dst, b, h) do { _Pragma("unroll") for (int n = 0; n < 2; ++n) _Pragma("unroll") for (int k = 0; k < 2; ++k) dst[n][k] = *(const PG8_LAS bf16x8*)(lds + PG8_SB(b, h) + boff + n * 2048 + k * 1024); } while (0)
#define PG8_MMA(ai, bj, At, Bt) do { __builtin_amdgcn_s_setprio(1); _Pragma("unroll") for (int m = 0; m < 4; ++m) _Pragma("unroll") for (int n = 0; n < 2; ++n) _Pragma("unroll") for (int k = 0; k < 2; ++k) \
        acc[ai][bj][m][n] = __builtin_amdgcn_mfma_f32_16x16x32_bf16(Bt[n][k], At[m][k], acc[ai][bj][m][n], 0, 0, 0); __builtin_amdgcn_s_setprio(0); } while (0)
#define PG8_WAIT_V(n) asm volatile("s_waitcnt vmcnt(" #n ")" ::: "memory")
#define PG8_WAIT_L(n) asm volatile("s_waitcnt lgkmcnt(" #n ")" ::: "memory")
#define PG8_BAR __builtin_amdgcn_s_barrier()
#define PG8_SCHED __builtin_amdgcn_sched_barrier(0)
    Unit cur, nxt; int ui = 0;
    if (!S.next(0, cur)) return;
    f32x4 acc[2][2][4][2];
#pragma unroll
    for (int a = 0; a < 2; ++a)
#pragma unroll
        for (int b = 0; b < 2; ++b)
#pragma unroll
            for (int m = 0; m < 4; ++m)
#pragma unroll
                for (int n = 0; n < 2; ++n) acc[a][b][m][n] = (f32x4){0.f, 0.f, 0.f, 0.f};
    bf16x8 At[4][2], B0[2][2], B1[2][2];
    const char* cA = (const char*)g.A + (size_t)cur.pm * tstep; const char* cB = (const char*)g.Bt + (size_t)cur.pn * tstep;
    S.a_ready(cur);
    if constexpr (SP2) {
        PG8_STAGE(PG8_SB(0, 0), cB, voffB); PG8_STAGE(PG8_SB(0, 1), cB + hstep, voffB); PG8_STAGE(PG8_SA(0, 0), cA, voffA); PG8_STAGE(PG8_SA(0, 1), cA + hstep, voffA);
        if (wr == 1) PG8_BAR;
        PG8_WAIT_V(2); PG8_BAR;
        PG8_STAGE(PG8_SB(1, 0), cB + kstep, voffB); PG8_STAGE(PG8_SA(1, 0), cA + kstep, voffA); PG8_STAGE(PG8_SB(1, 1), cB + hstep + kstep, voffB);
        PG8_WAIT_V(6); PG8_BAR;
    } else {
        PG8_STAGE(PG8_SB(0, 0), cB, voffB); PG8_STAGE(PG8_SA(0, 0), cA, voffA); PG8_STAGE(PG8_SB(0, 1), cB + hstep, voffB); PG8_STAGE(PG8_SA(0, 1), cA + hstep, voffA);
        if (wr == 1) PG8_BAR;
        PG8_WAIT_V(4); PG8_BAR;
        PG8_STAGE(PG8_SB(1, 0), cB + kstep, voffB); PG8_STAGE(PG8_SA(1, 0), cA + kstep, voffA); PG8_STAGE(PG8_SB(1, 1), cB + hstep + kstep, voffB);
        PG8_WAIT_V(6); PG8_BAR;
    }
    for (;;) {
        const bool has_next = S.next(ui + 1, nxt);
        const char* nA = has_next ? (const char*)g.A + (size_t)nxt.pm * tstep : cA; const char* nB = has_next ? (const char*)g.Bt + (size_t)nxt.pn * tstep : cB;
        for (int t = 0; t < nt; t += 2) {
            const bool last = (t == nt - 2);
            const char* a1 = cA + (size_t)(t + 1) * kstep;
            const char* a2 = last ? nA : cA + (size_t)(t + 2) * kstep; const char* b2 = last ? nB : cB + (size_t)(t + 2) * kstep;
            const char* a3 = a2 + kstep; const char* b3 = b2 + kstep;
            if (last && has_next) S.a_ready(nxt);
            if constexpr (SP2) {
            PG8_LDB(B0, 0, 0); PG8_LDB(B1, 0, 1); PG8_SCHED; PG8_LDA(At, 0, 0); PG8_STAGE(PG8_SA(1, 1), a1 + hstep, voffA);
            PG8_WAIT_V(8); PG8_WAIT_L(0); PG8_BAR; PG8_MMA(0, 0, At, B0); PG8_MMA(0, 1, At, B1); PG8_BAR; PG8_SCHED;
            PG8_LDA(At, 0, 1); PG8_STAGE(PG8_SB(0, 0), b2, voffB); PG8_STAGE(PG8_SB(0, 1), b2 + hstep, voffB); PG8_STAGE(PG8_SA(0, 0), a2, voffA);
            PG8_WAIT_V(8); PG8_WAIT_L(0); PG8_BAR; PG8_MMA(1, 0, At, B0); PG8_MMA(1, 1, At, B1); PG8_BAR; PG8_SCHED;
            PG8_LDB(B0, 1, 0); PG8_LDB(B1, 1, 1); PG8_SCHED; PG8_LDA(At, 1, 0); PG8_STAGE(PG8_SA(0, 1), a2 + hstep, voffA);
            PG8_WAIT_V(8); PG8_WAIT_L(0); PG8_BAR; PG8_MMA(0, 0, At, B0); PG8_MMA(0, 1, At, B1); PG8_BAR; PG8_SCHED;
            PG8_LDA(At, 1, 1); PG8_STAGE(PG8_SB(1, 0), b3, voffB); PG8_STAGE(PG8_SB(1, 1), b3 + hstep, voffB); PG8_STAGE(PG8_SA(1, 0), a3, voffA);
            PG8_WAIT_V(8); PG8_WAIT_L(0); PG8_BAR; PG8_MMA(1, 0, At, B0); PG8_MMA(1, 1, At, B1); PG8_BAR; PG8_SCHED;
            } else {
            PG8_LDB(B0, 0, 0); PG8_SCHED; PG8_LDA(At, 0, 0); PG8_STAGE(PG8_SA(1, 1), a1 + hstep, voffA);
            PG8_WAIT_L(8); PG8_BAR; PG8_WAIT_L(0); PG8_MMA(0, 0, At, B0); PG8_BAR; PG8_SCHED;
            PG8_LDB(B1, 0, 1); PG8_STAGE(PG8_SB(0, 0), b2, voffB);
            PG8_BAR; PG8_WAIT_L(0); PG8_MMA(0, 1, At, B1); PG8_BAR;
            PG8_LDA(At, 0, 1); PG8_STAGE(PG8_SA(0, 0), a2, voffA);
            PG8_BAR; PG8_WAIT_L(0); PG8_MMA(1, 0, At, B0); PG8_BAR; PG8_SCHED;
            PG8_STAGE(PG8_SB(0, 1), b2 + hstep, voffB);
            PG8_WAIT_V(6); PG8_BAR; PG8_MMA(1, 1, At, B1); PG8_BAR;
            PG8_LDB(B0, 1, 0); PG8_SCHED; PG8_LDA(At, 1, 0); PG8_STAGE(PG8_SA(0, 1), a2 + hstep, voffA);
            PG8_WAIT_L(8); PG8_BAR; PG8_WAIT_L(0); PG8_MMA(0, 0, At, B0); PG8_BAR; PG8_SCHED;
            PG8_LDB(B1, 1, 1); PG8_STAGE(PG8_SB(1, 0), b3, voffB);
            PG8_BAR; PG8_WAIT_L(0); PG8_MMA(0, 1, At, B1); PG8_BAR;
            PG8_LDA(At, 1, 1); PG8_STAGE(PG8_SA(1, 0), a3, voffA);
            PG8_BAR; PG8_WAIT_L(0); PG8_MMA(1, 0, At, B0); PG8_BAR; PG8_SCHED;
            PG8_STAGE(PG8_SB(1, 1), b3 + hstep, voffB);
            PG8_WAIT_V(6); PG8_BAR; PG8_MMA(1, 1, At, B1); PG8_BAR;
            }
        }
        if constexpr (ALIGN_EPI) { if (wr == 0) PG8_BAR; }
        if constexpr (!Epi::AFTER_DRAIN) { E(acc, cur, wr, wc, fr, fq); S.done(cur); }
        if (!has_next) break;
#pragma unroll
        for (int a = 0; a < 2; ++a)
#pragma unroll
            for (int b = 0; b < 2; ++b)
#pragma unroll
                for (int m = 0; m < 4; ++m)
#pragma unroll
                    for (int n = 0; n < 2; ++n) acc[a][b][m][n] = (f32x4){0.f, 0.f, 0.f, 0.f};
        cur = nxt; cA = nA; cB = nB; ++ui;
        if constexpr (ALIGN_EPI) { if (wr == 1) PG8_BAR; }
    }
    PG8_WAIT_V(0);
    if constexpr (!ALIGN_EPI) { if (wr == 0) PG8_BAR; }
    PG8_BAR;
    if constexpr (Epi::AFTER_DRAIN) { E.fused(acc, cur, wr, wc, fr, fq, lds, wid, lane); S.done(cur); }
#undef PG8_SA
#undef PG8_SB
#undef PG8_STAGE
#undef PG8_LDA
#undef PG8_LDB
#undef PG8_MMA
#undef PG8_WAIT_V
#undef PG8_WAIT_L
#undef PG8_BAR
#undef PG8_SCHED
}
}

namespace fa {
typedef unsigned short bf16_t;
typedef short bf16x8 __attribute__((ext_vector_type(8)));
typedef short s16x4 __attribute__((ext_vector_type(4)));
typedef float f32x16 __attribute__((ext_vector_type(16)));
typedef float f32x4 __attribute__((ext_vector_type(4)));
typedef unsigned u32x4 __attribute__((ext_vector_type(4)));
constexpr int LDQ = 7168, LDO = 2048, SEQ = 2048;
constexpr float SCALE = 0.08838834764831845f;
constexpr float LOG2E = 1.4426950408889634f;
#define SBAR() __builtin_amdgcn_sched_barrier(0)
#define FA_LAS __attribute__((address_space(3)))
template <int NCB> __device__ __forceinline__ int v_st(int k, int c) { const int kk = (k & ~0xC) | ((k & 4) << 1) | ((k & 8) >> 1); return ((kk >> 3) * NCB + (c >> 5)) * 512 + ((kk & 7) * 32 + (c & 31)) * 2; }
__device__ __forceinline__ int v_rd_base(int lane) { return ((lane & 3) << 3) | (((lane >> 2) & 3) << 6) | (((lane >> 4) & 1) << 5) | (((lane >> 5) & 1) << 8); }
__device__ __forceinline__ int crow(int r, int hi) { return (r & 3) + 8 * (r >> 2) + 4 * hi; }
__device__ __forceinline__ unsigned cvtpk(float lo, float hi) { unsigned r; asm volatile("v_cvt_pk_bf16_f32 %0, %1, %2" : "=v"(r) : "v"(lo), "v"(hi)); return r; }
__device__ __forceinline__ float bf2f(bf16_t v) { return __uint_as_float(((unsigned)v) << 16); }

template <int CLS> __device__ __forceinline__ void bias_tile(f32x16& p0, f32x16& p1, int dq, float slr, int dq15, int dq3) {
    const float NEG = -__builtin_inff(); const float L2R = 0.6931471805599453f / SCALE, L3R = 1.0986122886681098f / SCALE;
#pragma unroll
    for (int r = 0; r < 16; ++r) {
#pragma unroll
        for (int hf = 0; hf < 2; ++hf) {
            const int C = (r & 3) + 8 * (r >> 2) + 32 * hf;
            float v = hf ? p1[r] : p0[r];
            v = __builtin_fmaf(slr, (float)C, v);
            const bool m16 = dq15 == (C & 15), m4 = dq3 == (C & 3);
            if (CLS == 2) { v = m16 ? v : NEG; }
            else if (CLS == 1) { const float v2 = v + L2R; v = m16 ? v2 : v; v = m4 ? v : NEG; }
            else if (CLS == 3 || CLS == 4) { float bb = m4 ? L2R : 0.f; bb = m16 ? L3R : bb; v += bb; if (CLS == 4) v = (dq >= C) ? v : NEG; }
            else if (CLS == 5) { const bool n1 = dq <= C + 128; const float b16 = n1 ? L3R : L2R, b4 = n1 ? L2R : 0.f, b1 = n1 ? 0.f : NEG; v += m16 ? b16 : (m4 ? b4 : b1); }
            else { const bool n5 = dq <= C + 512; const float b16 = n5 ? L2R : 0.f, b4 = n5 ? 0.f : NEG; v += m16 ? b16 : (m4 ? b4 : NEG); }
            if (hf) p1[r] = v; else p0[r] = v;
        }
    }
}
constexpr float THR = 8.f;
__device__ __forceinline__ void partialSM(f32x16& p0, f32x16& p1, float& m_reg, float& mn, float& alpha) {
    float pmax = p0[0];
#pragma unroll
    for (int r = 1; r < 16; ++r) pmax = fmaxf(pmax, p0[r]);
#pragma unroll
    for (int r = 0; r < 16; ++r) pmax = fmaxf(pmax, p1[r]);
    { auto rr = __builtin_amdgcn_permlane32_swap(__float_as_uint(pmax), __float_as_uint(pmax), false, false);
      pmax = fmaxf(__uint_as_float(rr[0]), __uint_as_float(rr[1])); }
    constexpr float C2 = LOG2E * SCALE;
    if (__builtin_expect(__all((pmax - m_reg) * SCALE <= THR), 1)) { mn = m_reg; alpha = 1.f; }
    else { mn = fmaxf(m_reg, pmax); alpha = __builtin_amdgcn_exp2f((m_reg - mn) * C2); m_reg = mn; }
    const float mnL = -mn * C2;
#pragma unroll
    for (int r = 0; r < 16; ++r) p0[r] = __builtin_fmaf(p0[r], C2, mnL);
#pragma unroll
    for (int r = 0; r < 16; ++r) p1[r] = __builtin_fmaf(p1[r], C2, mnL);
#pragma unroll
    for (int r = 0; r < 16; ++r) p0[r] = __builtin_amdgcn_exp2f(p0[r]);
#pragma unroll
    for (int r = 0; r < 16; ++r) p1[r] = __builtin_amdgcn_exp2f(p1[r]);
}
#define FA_PK4(P, B_, OUT) do { unsigned a0 = cvtpk(P[B_+0], P[B_+1]), a1 = cvtpk(P[B_+2], P[B_+3]);                          \
        unsigned b0 = cvtpk(P[B_+4], P[B_+5]), b1 = cvtpk(P[B_+6], P[B_+7]);                                             \
        auto r0 = __builtin_amdgcn_permlane32_swap(a0, b0, false, false); auto r1 = __builtin_amdgcn_permlane32_swap(a1, b1, false, false); \
        u32x4 w = {r0[0], r1[0], r0[1], r1[1]}; OUT = *reinterpret_cast<bf16x8*>(&w); } while (0)
__device__ __forceinline__ void pack_p(const f32x16& p0, const f32x16& p1, bf16x8& pa0, bf16x8& pa1, bf16x8& pa2, bf16x8& pa3) {
    FA_PK4(p0, 0, pa0); FA_PK4(p0, 8, pa1); FA_PK4(p1, 0, pa2); FA_PK4(p1, 8, pa3);
}
__device__ __forceinline__ void finishSM(f32x16& p0, f32x16& p1, float alpha, float& l_reg, bf16x8& pa0, bf16x8& pa1, bf16x8& pa2, bf16x8& pa3) {
    float ps = 0;
#pragma unroll
    for (int r = 0; r < 16; ++r) ps += p0[r];
#pragma unroll
    for (int r = 0; r < 16; ++r) ps += p1[r];
    { auto rr = __builtin_amdgcn_permlane32_swap(__float_as_uint(ps), __float_as_uint(ps), false, false);
      ps = __uint_as_float(rr[0]) + __uint_as_float(rr[1]); }
    l_reg = l_reg * alpha + ps;
    pack_p(p0, p1, pa0, pa1, pa2, pa3);
}
template <int NF, int RB>
__device__ __forceinline__ void qkt(f32x16& p0, f32x16& p1, const char* Kt, int r32, int hi, const bf16x8* qr, float init) {
#pragma unroll
    for (int r = 0; r < 16; ++r) { p0[r] = init; p1[r] = init; }
    const char* kb[4];
#pragma unroll
    for (int dd = 0; dd < 4; ++dd) kb[dd] = Kt + r32 * RB + (((dd * 16 + hi * 8) * 2) ^ ((r32 & 7) << 4));
#pragma unroll
    for (int d0 = 0; d0 < NF; ++d0) { const char* a = kb[d0 & 3] + (d0 >> 2) * 128;
        bf16x8 b0 = *reinterpret_cast<const bf16x8*>(a);
        bf16x8 b1 = *reinterpret_cast<const bf16x8*>(a + 32 * RB);
        p0 = __builtin_amdgcn_mfma_f32_32x32x16_bf16(b0, qr[d0], p0, 0, 0, 0);
        p1 = __builtin_amdgcn_mfma_f32_32x32x16_bf16(b1, qr[d0], p1, 0, 0, 0); }
}
template <int NF, int RB>
__device__ __forceinline__ void qkt1(f32x16& p, const char* Kt, int r32, int hi, const bf16x8* qr) {
#pragma unroll
    for (int r = 0; r < 16; ++r) p[r] = 0.f;
    const char* kb[4];
#pragma unroll
    for (int dd = 0; dd < 4; ++dd) kb[dd] = Kt + r32 * RB + (((dd * 16 + hi * 8) * 2) ^ ((r32 & 7) << 4));
#pragma unroll
    for (int d0 = 0; d0 < NF; ++d0) { const bf16x8 b0 = *reinterpret_cast<const bf16x8*>(kb[d0 & 3] + (d0 >> 2) * 128);
        p = __builtin_amdgcn_mfma_f32_32x32x16_bf16(b0, qr[d0], p, 0, 0, 0); }
}
template <int KS, int HF>
__device__ __forceinline__ void pv_tile(f32x16* o, int vb, bf16x8 pa0, bf16x8 pa1, bf16x8 pa2, bf16x8 pa3) {
#define FA_TRRD(dst, off) asm volatile("ds_read_b64_tr_b16 %0, %1 offset:%2" : "=&v"(dst) : "v"(vb), "i"(off) : "memory")
#define FA_PV_D0(d0) do { s16x4 l0, l1, l2, l3, h0, h1, h2, h3; constexpr int b_ = (d0) * 512; \
        FA_TRRD(l0, b_); FA_TRRD(h0, b_ + HF); FA_TRRD(l1, b_ + KS); FA_TRRD(h1, b_ + KS + HF); FA_TRRD(l2, b_ + 2 * KS); FA_TRRD(h2, b_ + 2 * KS + HF); FA_TRRD(l3, b_ + 3 * KS); FA_TRRD(h3, b_ + 3 * KS + HF); \
        asm volatile("s_waitcnt lgkmcnt(0)" ::: "memory"); SBAR();   \
        o[d0] = __builtin_amdgcn_mfma_f32_32x32x16_bf16(pa0, (bf16x8){l0[0], l0[1], l0[2], l0[3], h0[0], h0[1], h0[2], h0[3]}, o[d0], 0, 0, 0);   \
        o[d0] = __builtin_amdgcn_mfma_f32_32x32x16_bf16(pa1, (bf16x8){l1[0], l1[1], l1[2], l1[3], h1[0], h1[1], h1[2], h1[3]}, o[d0], 0, 0, 0);   \
        o[d0] = __builtin_amdgcn_mfma_f32_32x32x16_bf16(pa2, (bf16x8){l2[0], l2[1], l2[2], l2[3], h2[0], h2[1], h2[2], h2[3]}, o[d0], 0, 0, 0);   \
        o[d0] = __builtin_amdgcn_mfma_f32_32x32x16_bf16(pa3, (bf16x8){l3[0], l3[1], l3[2], l3[3], h3[0], h3[1], h3[2], h3[3]}, o[d0], 0, 0, 0); } while (0)
    FA_PV_D0(0); FA_PV_D0(1); FA_PV_D0(2); FA_PV_D0(3);
#undef FA_PV_D0
#undef FA_TRRD
}

__device__ __forceinline__ void attn_block(const bf16_t* __restrict__ proj, bf16_t* __restrict__ mixed, int b, int h, int qb, char* lds) {
    int tid_ = threadIdx.x; asm volatile("" : "+v"(tid_));
    const int tid = tid_, wid = __builtin_amdgcn_readfirstlane(tid >> 6), lane = tid & 63, r32 = lane & 31, hi = lane >> 5;
    constexpr int SHM = 16384;
    char* V_lds = lds; char* K_lds = lds + 2 * SHM;
    float* wsf = (float*)(lds + 65536) + wid * 64; float* li_l = wsf; float* al_l = wsf + 32;
    const bf16_t* Qp = proj + (size_t)(b * SEQ + qb * 256) * LDQ + h * 128;
    const bf16_t* Kp = proj + (size_t)(b * SEQ) * LDQ + 1024 + h * 128;
    const bf16_t* Vp = Kp + 1024;
    bf16_t* Op = mixed + (size_t)(b * SEQ + qb * 256 + wid * 32) * LDO + h * 128;
    const int NT = 4 * (qb + 1);
    const int qlo = qb * 256 + wid * 32, qm = qlo + r32 - 4 * hi;
    const float slr = __builtin_amdgcn_exp2f(-(float)(h + 1)) * (1.0f / SCALE);
    bf16x8 qr[8];
#pragma unroll
    for (int d0 = 0; d0 < 8; ++d0) qr[d0] = *(const bf16x8*)(Qp + (size_t)(wid * 32 + r32) * LDQ + d0 * 16 + hi * 8);
    const int lb = wid * 1024 + lane * 16;
    const int krow = lb >> 8, kch = ((lb >> 4) & 15) ^ (krow & 7);
    const bf16_t* kg = Kp + (size_t)krow * LDQ + kch * 8;
    const int stv = lb >> 9, kkv = ((stv >> 2) << 3) | ((lb >> 6) & 7), kvv = (kkv & ~0xC) | ((kkv & 4) << 1) | ((kkv & 8) >> 1);
    const bf16_t* vg = Vp + (size_t)kvv * LDQ + (stv & 3) * 32 + ((lb >> 4) & 3) * 8;
#define FA_DMA(k0, bf) do { _Pragma("unroll") for (int i_ = 0; i_ < 2; ++i_) { \
        __builtin_amdgcn_global_load_lds((const unsigned*)(kg + (size_t)((k0) + 32 * i_) * LDQ), (FA_LAS unsigned*)(K_lds + (bf) * SHM + i_ * 8192 + wid * 1024), 16, 0, 0); \
        __builtin_amdgcn_global_load_lds((const unsigned*)(vg + (size_t)((k0) + 32 * i_) * LDQ), (FA_LAS unsigned*)(V_lds + (bf) * SHM + i_ * 8192 + wid * 1024), 16, 0, 0); } } while (0)
    FA_DMA(0, 0);
    asm volatile("s_waitcnt vmcnt(0)" ::: "memory");
    __syncthreads();
    float m_reg = -1e30f, l_reg = 0.f; f32x16 o[4];
#pragma unroll
    for (int d = 0; d < 4; ++d)
#pragma unroll
        for (int r = 0; r < 16; ++r) o[d][r] = 0.f;
    const int vb0 = (int)(uintptr_t)V_lds + v_rd_base(lane);
    const int dq15 = qm & 15, dq3 = qm & 3, r0 = (dq15 & 3) + 4 * (dq15 >> 3);
    const bool lane_valid = (dq15 & 4) == 0, r0odd = (r0 & 1) != 0;
    const bool is1 = r0 == 1, is2 = r0 == 2, is3 = r0 == 3, is4 = r0 == 4, is5 = r0 == 5, is6 = r0 == 6, is7 = r0 == 7;
    const bool rp0 = (r0 >> 1) == 0, rp1 = (r0 >> 1) == 1, rp2 = (r0 >> 1) == 2, rp3 = (r0 >> 1) == 3;
    const float fc0 = slr * (float)((r0 & 3) + 8 * (r0 >> 2));
    for (int t = 0; t < NT; ++t) {
        const int buf = t & 1, kb = t * 64;
        if (t + 1 < NT) FA_DMA(kb + 64, buf ^ 1);
        if (kb <= qlo + 31) {
            f32x16 p0, p1; const int dq = qm - kb;
            qkt<8, 256>(p0, p1, K_lds + buf * SHM, r32, hi, qr, -slr * (float)dq);
            const int dmin = qlo - kb - 63, dmax = qlo + 31 - kb;
            float alpha; bf16x8 pa0, pa1, pa2, pa3;
            if (dmin > 512) {
#define FA_SEL8(P, B_) ({ float v_ = P[B_]; v_ = is1 ? P[B_ + 1] : v_; v_ = is2 ? P[B_ + 2] : v_; v_ = is3 ? P[B_ + 3] : v_; v_ = is4 ? P[B_ + 4] : v_; v_ = is5 ? P[B_ + 5] : v_; v_ = is6 ? P[B_ + 6] : v_; v_ = is7 ? P[B_ + 7] : v_; v_; })
                const float NEG = -__builtin_inff();
                float e0 = FA_SEL8(p0, 0) + fc0, e1 = FA_SEL8(p0, 8) + (fc0 + 16.f * slr), e2 = FA_SEL8(p1, 0) + (fc0 + 32.f * slr), e3 = FA_SEL8(p1, 8) + (fc0 + 48.f * slr);
#undef FA_SEL8
                e0 = lane_valid ? e0 : NEG; e1 = lane_valid ? e1 : NEG; e2 = lane_valid ? e2 : NEG; e3 = lane_valid ? e3 : NEG;
                float pmax = fmaxf(fmaxf(e0, e1), fmaxf(e2, e3));
                { auto rr = __builtin_amdgcn_permlane32_swap(__float_as_uint(pmax), __float_as_uint(pmax), false, false); pmax = fmaxf(__uint_as_float(rr[0]), __uint_as_float(rr[1])); }
                constexpr float C2 = LOG2E * SCALE; float mn;
                if (__builtin_expect(__all((pmax - m_reg) * SCALE <= THR), 1)) { mn = m_reg; alpha = 1.f; }
                else { mn = fmaxf(m_reg, pmax); alpha = __builtin_amdgcn_exp2f((m_reg - mn) * C2); m_reg = mn; }
                const float mnL = -mn * C2;
                e0 = __builtin_amdgcn_exp2f(__builtin_fmaf(e0, C2, mnL)); e1 = __builtin_amdgcn_exp2f(__builtin_fmaf(e1, C2, mnL));
                e2 = __builtin_amdgcn_exp2f(__builtin_fmaf(e2, C2, mnL)); e3 = __builtin_amdgcn_exp2f(__builtin_fmaf(e3, C2, mnL));
                float ps = (e0 + e1) + (e2 + e3);
                { auto rr = __builtin_amdgcn_permlane32_swap(__float_as_uint(ps), __float_as_uint(ps), false, false); ps = __uint_as_float(rr[0]) + __uint_as_float(rr[1]); }
                l_reg = l_reg * alpha + ps;
#define FA_SCAT(E_, OUT) do { unsigned w_ = cvtpk(E_, 0.f); w_ = r0odd ? (w_ << 16) : w_; \
                    const unsigned a0 = rp0 ? w_ : 0u, a1 = rp1 ? w_ : 0u, b0 = rp2 ? w_ : 0u, b1 = rp3 ? w_ : 0u; \
                    auto s0 = __builtin_amdgcn_permlane32_swap(a0, b0, false, false); auto s1 = __builtin_amdgcn_permlane32_swap(a1, b1, false, false); \
                    u32x4 ww = {s0[0], s1[0], s0[1], s1[1]}; OUT = *reinterpret_cast<bf16x8*>(&ww); } while (0)
                FA_SCAT(e0, pa0); FA_SCAT(e1, pa1); FA_SCAT(e2, pa2); FA_SCAT(e3, pa3);
#undef FA_SCAT
            } else {
                if (dmin < 0) bias_tile<4>(p0, p1, dq, slr, dq15, dq3);
                else if (dmax <= 128) bias_tile<3>(p0, p1, dq, slr, dq15, dq3);
                else if (dmin <= 128) bias_tile<5>(p0, p1, dq, slr, dq15, dq3);
                else if (dmax <= 512) bias_tile<1>(p0, p1, dq, slr, dq15, dq3);
                else bias_tile<6>(p0, p1, dq, slr, dq15, dq3);
                float mn; partialSM(p0, p1, m_reg, mn, alpha);
                finishSM(p0, p1, alpha, l_reg, pa0, pa1, pa2, pa3);
            }
            if (__any(alpha < 1.f)) { if (hi == 0) al_l[r32] = alpha; asm volatile("s_waitcnt lgkmcnt(0)" ::: "memory");
#pragma unroll
                for (int d_ = 0; d_ < 4; ++d_)
#pragma unroll
                    for (int r = 0; r < 16; ++r) o[d_][r] *= al_l[crow(r, hi)]; }
            pv_tile<4096, 2048>(o, vb0 + buf * SHM, pa0, pa1, pa2, pa3);
        }
        asm volatile("s_waitcnt vmcnt(0)" ::: "memory");
        __syncthreads();
    }
#undef FA_DMA
    if (hi == 0) li_l[r32] = l_reg; asm volatile("s_waitcnt lgkmcnt(0)" ::: "memory");
#pragma unroll
    for (int r = 0; r < 16; ++r) { const int orow = crow(r, hi); const float rl = __builtin_amdgcn_rcpf(li_l[orow]);
#pragma unroll
        for (int d0 = 0; d0 < 4; ++d0) { const float v = o[d0][r] * rl; const float vn = __shfl_xor(v, 1);
            if ((r32 & 1) == 0) *(unsigned*)(Op + (size_t)orow * LDO + d0 * 32 + r32) = cvtpk(v, vn); } }
    __syncthreads();
}

__device__ __forceinline__ void ret_state_scan(const bf16_t* __restrict__ proj, bf16_t* __restrict__ state, int b, int h, int d4, int e2, char* lds) {
    int tid_ = threadIdx.x; asm volatile("" : "+v"(tid_));
    const int tid = tid_, wid = __builtin_amdgcn_readfirstlane(tid >> 6), lane = tid & 63, r32 = lane & 31, hi = lane >> 5;
    const int wd = wid & 1, we = wid >> 1;
    constexpr int STG = 24576;
    const bf16_t* Kp = proj + (size_t)(b * SEQ) * LDQ + 4096 + h * 256 + d4 * 64;
    const bf16_t* Vp = proj + (size_t)(b * SEQ) * LDQ + 5120 + h * 256 + e2 * 128;
    bf16_t* Sp = state + ((size_t)((b * 4 + h) * 16) * 256 + d4 * 64 + wd * 32) * 256 + e2 * 128 + we * 32;
    const int lb = wid * 1024 + lane * 16, stv = lb >> 9, rowin = (lb >> 6) & 7, ch = (lb >> 4) & 3;
    const int kkk = ((stv >> 1) << 3) | rowin, keyk = (kkk & ~0xC) | ((kkk & 4) << 1) | ((kkk & 8) >> 1);
    const bf16_t* kg = Kp + (size_t)keyk * LDQ + (stv & 1) * 32 + ch * 8;
    const int kkv = ((stv >> 2) << 3) | rowin, keyv = (kkv & ~0xC) | ((kkv & 4) << 1) | ((kkv & 8) >> 1);
    const bf16_t* vg = Vp + (size_t)keyv * LDQ + (stv & 3) * 32 + ch * 8;
#define FA_DMA(st_, sg_) do { char* base_ = lds + (sg_) * STG; const size_t k0_ = (size_t)(st_) * 64 * LDQ; \
        __builtin_amdgcn_global_load_lds((const unsigned*)(kg + k0_), (FA_LAS unsigned*)(base_ + wid * 1024), 16, 0, 0); \
        __builtin_amdgcn_global_load_lds((const unsigned*)(vg + k0_), (FA_LAS unsigned*)(base_ + 8192 + wid * 1024), 16, 0, 0); \
        __builtin_amdgcn_global_load_lds((const unsigned*)(vg + k0_ + (size_t)32 * LDQ), (FA_LAS unsigned*)(base_ + 16384 + wid * 1024), 16, 0, 0); } while (0)
    f32x16 R;
#pragma unroll
    for (int r = 0; r < 16; ++r) R[r] = 0.f;
    const int rb = (int)(uintptr_t)lds + v_rd_base(lane);
    FA_DMA(0, 0); FA_DMA(1, 1);
    for (int st = 0; st < 32; ++st) {
        if ((st & 1) == 0 && st > 0) {
            bf16_t* dst = Sp + (size_t)(st >> 1) * 65536;
#pragma unroll
            for (int r = 0; r < 16; ++r) { const float v = R[r]; const float vn = __shfl_xor(v, 1);
                if ((r32 & 1) == 0) *(unsigned*)(dst + (size_t)crow(r, hi) * 256 + r32) = cvtpk(v, vn); } }
        if (st + 2 < 32) { FA_DMA(st + 2, (st + 2) & 3); asm volatile("s_waitcnt vmcnt(6)" ::: "memory"); }
        else asm volatile("s_waitcnt vmcnt(0)" ::: "memory");
        __builtin_amdgcn_s_barrier(); asm volatile("" ::: "memory");
        const int ka = rb + (st & 3) * STG + wd * 512, va = rb + (st & 3) * STG + 8192 + we * 512;
#define FA_TR(dst, base, off) asm volatile("ds_read_b64_tr_b16 %0, %1 offset:%2" : "=&v"(dst) : "v"(base), "i"(off) : "memory")
        s16x4 al[4], ah[4], bl[4], bh[4];
        FA_TR(al[0], ka, 0); FA_TR(ah[0], ka, 1024); FA_TR(al[1], ka, 2048); FA_TR(ah[1], ka, 3072); FA_TR(al[2], ka, 4096); FA_TR(ah[2], ka, 5120); FA_TR(al[3], ka, 6144); FA_TR(ah[3], ka, 7168);
        FA_TR(bl[0], va, 0); FA_TR(bh[0], va, 2048); FA_TR(bl[1], va, 4096); FA_TR(bh[1], va, 6144); FA_TR(bl[2], va, 8192); FA_TR(bh[2], va, 10240); FA_TR(bl[3], va, 12288); FA_TR(bh[3], va, 14336);
        asm volatile("s_waitcnt lgkmcnt(0)" ::: "memory"); SBAR();
#pragma unroll
        for (int ks = 0; ks < 4; ++ks)
            R = __builtin_amdgcn_mfma_f32_32x32x16_bf16((bf16x8){al[ks][0], al[ks][1], al[ks][2], al[ks][3], ah[ks][0], ah[ks][1], ah[ks][2], ah[ks][3]},
                                                        (bf16x8){bl[ks][0], bl[ks][1], bl[ks][2], bl[ks][3], bh[ks][0], bh[ks][1], bh[ks][2], bh[ks][3]}, R, 0, 0, 0);
#undef FA_TR
    }
#undef FA_DMA
    __syncthreads();
}

__device__ __forceinline__ void ret_block(const bf16_t* __restrict__ proj, const bf16_t* __restrict__ state, bf16_t* __restrict__ mixed, int b, int h, int qb, char* lds) {
    int tid_ = threadIdx.x; asm volatile("" : "+v"(tid_));
    const int tid = tid_, wid = __builtin_amdgcn_readfirstlane(tid >> 6), lane = tid & 63, r32 = lane & 31, hi = lane >> 5;
    const int wq = wid & 3, e = wid >> 2;
    constexpr int SHM = 32768;
    char* V_lds = lds; char* K_lds = lds + 2 * SHM; float* ssx = (float*)(lds + 131072);
    const bf16_t* Qp = proj + (size_t)(b * SEQ + qb * 128) * LDQ + 3072 + h * 256;
    const bf16_t* Kp = proj + (size_t)(b * SEQ + qb * 128) * LDQ + 4096 + h * 256;
    const bf16_t* Vp = Kp + 1024;
    const bf16_t* Gp = Qp + 3072 + (size_t)(wq * 32) * LDQ + e * 128;
    const bf16_t* Sp = state + (size_t)((b * 4 + h) * 16 + qb) * 65536;
    bf16_t* Op = mixed + (size_t)(b * SEQ + qb * 128 + wq * 32) * LDO + 1024 + h * 256 + e * 128;
    const int qlo = wq * 32, qm = qlo + r32 - 4 * hi;
    bf16x8 qr[16];
#pragma unroll
    for (int d0 = 0; d0 < 16; ++d0) qr[d0] = *(const bf16x8*)(Qp + (size_t)(wq * 32 + r32) * LDQ + d0 * 16 + hi * 8);
    const int lb = wid * 1024 + lane * 16;
    const int krow = lb >> 9, kch = ((lb >> 4) & 31) ^ (krow & 7);
    const bf16_t* kg = Kp + (size_t)krow * LDQ + kch * 8;
    const int stv = lb >> 9, kkv = ((stv >> 3) << 3) | ((lb >> 6) & 7), kvv = (kkv & ~0xC) | ((kkv & 4) << 1) | ((kkv & 8) >> 1);
    const bf16_t* vg = Vp + (size_t)kvv * LDQ + (stv & 7) * 32 + ((lb >> 4) & 3) * 8;
    const bf16_t* sg = Sp + (size_t)kvv * 256 + (stv & 7) * 32 + ((lb >> 4) & 3) * 8;
#define FA_DMA(k0, bf) do { _Pragma("unroll") for (int i_ = 0; i_ < 4; ++i_) { \
        __builtin_amdgcn_global_load_lds((const unsigned*)(kg + (size_t)((k0) + 16 * i_) * LDQ), (FA_LAS unsigned*)(K_lds + (bf) * SHM + i_ * 8192 + wid * 1024), 16, 0, 0); \
        __builtin_amdgcn_global_load_lds((const unsigned*)(vg + (size_t)((k0) + 16 * i_) * LDQ), (FA_LAS unsigned*)(V_lds + (bf) * SHM + i_ * 8192 + wid * 1024), 16, 0, 0); } } while (0)
#define FA_DMAS(j_, bf) do { _Pragma("unroll") for (int i_ = 0; i_ < 4; ++i_) \
        __builtin_amdgcn_global_load_lds((const unsigned*)(sg + (size_t)(64 * (j_) + 16 * i_) * 256), (FA_LAS unsigned*)(V_lds + (bf) * SHM + i_ * 8192 + wid * 1024), 16, 0, 0); } while (0)
#define FA_BAR() do { __builtin_amdgcn_s_barrier(); asm volatile("" ::: "memory"); } while (0)
#define FA_DMASX(j_, dstp) do { _Pragma("unroll") for (int i_ = 0; i_ < 4; ++i_) \
        __builtin_amdgcn_global_load_lds((const unsigned*)(sg + (size_t)(64 * (j_) + 16 * i_) * 256), (FA_LAS unsigned*)((dstp) + i_ * 8192 + wid * 1024), 16, 0, 0); } while (0)
    FA_DMA(0, 0); FA_DMA(64, 1);
    f32x16 o[4];
#pragma unroll
    for (int d = 0; d < 4; ++d)
#pragma unroll
        for (int r = 0; r < 16; ++r) o[d][r] = 0.f;
    const int vrd = v_rd_base(lane) + e * 2048;
    const int vbV = (int)(uintptr_t)V_lds + vrd, vbK = (int)(uintptr_t)K_lds + vrd;
    const bool has_state = qb > 0;
    asm volatile("s_waitcnt vmcnt(8)" ::: "memory"); FA_BAR();
#pragma unroll
    for (int t = 0; t < 2; ++t) {
        const int buf = t, kb = t * 64;
        if (kb <= qlo + 31) {
            const bool diag = kb + 63 > qlo; const int dq = qm - kb;
            bf16x8 pa0, pa1, pa2, pa3;
            { f32x16 p; qkt1<16, 512>(p, K_lds + buf * SHM, r32, hi, qr);
              if (diag) {
#pragma unroll
                  for (int r = 0; r < 16; ++r) { const int C = (r & 3) + 8 * (r >> 2); if (dq - C < 0) p[r] = 0.f; } }
              FA_PK4(p, 0, pa0); FA_PK4(p, 8, pa1); }
            { f32x16 p; qkt1<16, 512>(p, K_lds + buf * SHM + 32 * 512, r32, hi, qr);
              if (diag) {
#pragma unroll
                  for (int r = 0; r < 16; ++r) { const int C = (r & 3) + 8 * (r >> 2) + 32; if (dq - C < 0) p[r] = 0.f; } }
              FA_PK4(p, 0, pa2); FA_PK4(p, 8, pa3); }
            pv_tile<8192, 4096>(o, vbV + buf * SHM, pa0, pa1, pa2, pa3);
        }
        if (t == 0) {
            asm volatile("s_waitcnt lgkmcnt(0)" ::: "memory"); FA_BAR();
            if (has_state) { FA_DMASX(0, V_lds); FA_DMASX(1, K_lds); asm volatile("s_waitcnt vmcnt(8)" ::: "memory"); }
            else asm volatile("s_waitcnt vmcnt(0)" ::: "memory");
            FA_BAR();
        }
    }
    if (has_state) {
        asm volatile("s_waitcnt lgkmcnt(0)" ::: "memory"); FA_BAR();
        FA_DMASX(2, V_lds + SHM); FA_DMASX(3, K_lds + SHM);
        asm volatile("s_waitcnt vmcnt(12)" ::: "memory"); FA_BAR();
        pv_tile<8192, 4096>(o, vbV, qr[0], qr[1], qr[2], qr[3]);
        asm volatile("s_waitcnt vmcnt(8)" ::: "memory"); FA_BAR();
        pv_tile<8192, 4096>(o, vbK, qr[4], qr[5], qr[6], qr[7]);
        asm volatile("s_waitcnt vmcnt(4)" ::: "memory"); FA_BAR();
        pv_tile<8192, 4096>(o, vbV + SHM, qr[8], qr[9], qr[10], qr[11]);
        asm volatile("s_waitcnt vmcnt(0)" ::: "memory"); FA_BAR();
        pv_tile<8192, 4096>(o, vbK + SHM, qr[12], qr[13], qr[14], qr[15]);
    }
#undef FA_BAR
#undef FA_DMASX
#undef FA_DMA
#undef FA_DMAS
    bf16_t graw[16][4];
#pragma unroll
    for (int r = 0; r < 16; ++r)
#pragma unroll
        for (int d0 = 0; d0 < 4; ++d0) graw[r][d0] = Gp[(size_t)crow(r, hi) * LDQ + d0 * 32 + r32];
    float ssr[16];
#pragma unroll
    for (int r = 0; r < 16; ++r) { float s = 0.f;
#pragma unroll
        for (int d0 = 0; d0 < 4; ++d0) s += o[d0][r] * o[d0][r];
        s += __shfl_xor(s, 1); s += __shfl_xor(s, 2); s += __shfl_xor(s, 4); s += __shfl_xor(s, 8); s += __shfl_xor(s, 16);
        ssr[r] = s; }
    if (r32 == 0) {
#pragma unroll
        for (int r = 0; r < 16; ++r) ssx[e * 128 + wq * 32 + crow(r, hi)] = ssr[r]; }
    __syncthreads();
#pragma unroll
    for (int r = 0; r < 16; ++r) { const int orow = crow(r, hi); const float tot = ssx[wq * 32 + orow] + ssx[128 + wq * 32 + orow];
        const float rs = __builtin_amdgcn_rsqf(tot * (1.0f / 256.0f) + 1e-6f);
#pragma unroll
        for (int d0 = 0; d0 < 4; ++d0) { const float g = bf2f(graw[r][d0]);
            const float v = o[d0][r] * rs * g * __builtin_amdgcn_rcpf(1.0f + __builtin_amdgcn_exp2f(-LOG2E * g)); const float vn = __shfl_xor(v, 1);
            if ((r32 & 1) == 0) *(unsigned*)(Op + (size_t)orow * LDO + d0 * 32 + r32) = cvtpk(v, vn); } }
    __syncthreads();
}
#undef SBAR
}

#ifndef MK_N_LAUNCHES
#define MK_N_LAUNCHES 1
#endif
constexpr int NWAVES = 8, NPHASE = 8;
constexpr int BATCH = 8, SEQ = 2048, DM = 2048, M = BATCH * SEQ, NPROJ = 7168, FF = 5632, NGU = 2 * FF;
constexpr float NORM_EPS = 1e-6f;
constexpr size_t MiB = 1u << 20;
constexpr size_t WS_SS = 0, WS_BAR = 131072, CTL_ZERO_BYTES = 196608;
constexpr size_t WS_WIN = 1 * MiB, WS_WOUT = 29 * MiB, WS_WGU = 37 * MiB, WS_WDN = 81 * MiB;
constexpr size_t WS_H = 104 * MiB;
constexpr size_t WS_PROJ = 168 * MiB;
constexpr size_t WS_MIXED = 392 * MiB, WS_END = 456 * MiB;
constexpr int RING_BYTES = 131072, LDS_BYTES = 135168;

typedef unsigned short bf16;
typedef unsigned v4u __attribute__((ext_vector_type(4)));
typedef unsigned v2u __attribute__((ext_vector_type(2)));
typedef float f32x4 __attribute__((ext_vector_type(4)));
#define LAS __attribute__((address_space(3)))
__device__ __forceinline__ unsigned f2bf(float f) { unsigned u = __builtin_bit_cast(unsigned, f); return (u + 0x7fffu + ((u >> 16) & 1u)) >> 16; }
__device__ __forceinline__ unsigned pk2(float lo, float hi) { return f2bf(lo) | (f2bf(hi) << 16); }
__device__ __forceinline__ float wave_sum(float v) {
#pragma unroll
    for (int o = 1; o < 64; o <<= 1) v += __shfl_xor(v, o);
    return v;
}
#define XB_TMO      128
#define XB_XCNT(j)  (256  + 64 * (j))
#define XB_XSUB(j)  (1280 + 64 * (j))
#define XB_XGEN(j)  (2304 + 64 * (j))
#define XB_TOP      3328
#define XB_TOPGEN   3392
#define XCD_BAR_WORDS 3456
#define XB_SPIN_CAP (1u << 18)

__device__ __forceinline__ unsigned xb_ld(unsigned* p)              { return __hip_atomic_load(p, __ATOMIC_RELAXED, __HIP_MEMORY_SCOPE_AGENT); }
__device__ __forceinline__ unsigned xb_add(unsigned* p, unsigned v) { return __hip_atomic_fetch_add(p, v, __ATOMIC_RELAXED, __HIP_MEMORY_SCOPE_AGENT); }
__device__ __forceinline__ unsigned xb_xcc_id() { return (unsigned)__builtin_amdgcn_s_getreg((3 << 11) | 20) & 0xFu; }
#define XB_SPIN(cond, bar) do { unsigned _sp = 0; while (cond) { __builtin_amdgcn_s_sleep(1); \
    if ((++_sp & 255u) == 0u) { if (xb_ld(&(bar)[XB_TMO])) break; if (_sp > XB_SPIN_CAP) { atomicAdd(&(bar)[XB_TMO], 1u); break; } } } } while (0)

struct XcdBarrier {
    unsigned* bar; unsigned x;
    volatile LAS unsigned* st;
};

__device__ __forceinline__ XcdBarrier xcd_barrier_post(unsigned* bar, volatile LAS unsigned* st) {
    XcdBarrier b; b.bar = bar; b.x = xb_xcc_id(); b.st = st;
    if (threadIdx.x == 0) (void)xb_add(&bar[XB_XCNT(b.x)], 1u);
    return b;
}
__device__ __forceinline__ void xcd_barrier_complete(unsigned* bar, unsigned x, unsigned& nloc, unsigned& nx) {
    const unsigned G = gridDim.x * gridDim.y * gridDim.z;
    unsigned sum, cnt, mine, sp = 0u;
    for (;;) {
        sum = 0u; cnt = 0u; mine = 0u;
#pragma unroll
        for (unsigned j = 0; j < 16; ++j) { const unsigned c = xb_ld(&bar[XB_XCNT(j)]); sum += c; cnt += (c > 0u) ? 1u : 0u; mine = (j == x) ? c : mine; }
        if (sum == G) break;
        __builtin_amdgcn_s_sleep(1);
        if ((++sp & 255u) == 0u) { if (xb_ld(&bar[XB_TMO])) break; if (sp > XB_SPIN_CAP) { atomicAdd(&bar[XB_TMO], 1u); break; } }
    }
    nloc = mine > 0u ? mine : 1u; nx = cnt > 0u ? cnt : 1u;
}

__device__ __forceinline__ void xcd_barrier(const XcdBarrier& b) {
    asm volatile("s_waitcnt vmcnt(0)" ::: "memory");
    __syncthreads();
    if (threadIdx.x == 0) {
        unsigned* bar = b.bar;
        __builtin_amdgcn_s_waitcnt(0);
        unsigned nloc = b.st[0], nx = b.st[1];
        if (nloc == 0u) { xcd_barrier_complete(bar, b.x, nloc, nx); b.st[0] = nloc; b.st[1] = nx; }
        const unsigned old = xb_add(&bar[XB_XSUB(b.x)], 1u);
        const unsigned gen = old / nloc;
        if (old + 1u == (gen + 1u) * nloc) {
            __builtin_amdgcn_fence(__ATOMIC_RELEASE, "agent");
            asm volatile("s_waitcnt vmcnt(0)" ::: "memory");
            const unsigned og = xb_add(&bar[XB_TOP], 1u);
            const unsigned tg = og / nx;
            if (og + 1u == (tg + 1u) * nx) xb_add(&bar[XB_TOPGEN], 1u);
            else XB_SPIN(xb_ld(&bar[XB_TOPGEN]) == tg, bar);
            __builtin_amdgcn_fence(__ATOMIC_ACQUIRE, "agent");
            xb_add(&bar[XB_XGEN(b.x)], 1u);
            asm volatile("s_waitcnt vmcnt(0)" ::: "memory");
        } else {
            XB_SPIN(xb_ld(&bar[XB_XGEN(b.x)]) == gen, bar);
            __builtin_amdgcn_fence(__ATOMIC_ACQUIRE, "agent");
            asm volatile("s_waitcnt vmcnt(0)" ::: "memory");
        }
    }
    __syncthreads();
}

__device__ __forceinline__ unsigned cvtpk2(float lo, float hi) { unsigned r; asm volatile("v_cvt_pk_bf16_f32 %0, %1, %2" : "=v"(r) : "v"(lo), "v"(hi)); return r; }
__device__ __forceinline__ void p0_transpose_item(const float* __restrict__ W, int K, int N, bf16* __restrict__ WT, int mode, const float* __restrict__ kscale, int item, int lane) {
    const int nblk = N / 64, kb = item / nblk, nb = item % nblk, k0 = 64 * kb, n0 = 64 * nb;
    const float* src = W + (size_t)k0 * N + n0 + lane;
    float v[64];
#pragma unroll
    for (int i = 0; i < 64; ++i) v[i] = src[(size_t)i * N];
    if (kscale) {
#pragma unroll
        for (int i = 0; i < 64; ++i) v[i] *= kscale[k0 + i]; }
    const int rbase = (mode == 0) ? n0 : (256 * (n0 >> 7) + (n0 & 127) + (mode == 2 ? 128 : 0));
    bf16* dst = WT + (size_t)(rbase + lane) * K + k0;
#pragma unroll
    for (int j = 0; j < 8; ++j) { v4u o; o.x = cvtpk2(v[8 * j], v[8 * j + 1]); o.y = cvtpk2(v[8 * j + 2], v[8 * j + 3]); o.z = cvtpk2(v[8 * j + 4], v[8 * j + 5]); o.w = cvtpk2(v[8 * j + 6], v[8 * j + 7]);
        *(v4u*)(dst + 8 * j) = o; }
}

struct ConvOrder : pg8::StaticOrder {
    const float *w_out, *w_gate, *w_up, *w_down, *kscale; bf16 *Wout_t, *Wgu_t, *Wdn_t; int gw, ngw; mutable int nxt;
    static constexpr int I_OUT = (DM / 64) * (DM / 64), I_G = (DM / 64) * (FF / 64), I_DN = (FF / 64) * (DM / 64), NITEMS = I_OUT + 2 * I_G + I_DN;
    __device__ __forceinline__ void convert(int r, int lane) const {
        if (r < I_OUT) { p0_transpose_item(w_out, DM, DM, Wout_t, 0, nullptr, r, lane); return; } r -= I_OUT;
        if (r < I_G) { p0_transpose_item(w_gate, DM, FF, Wgu_t, 1, kscale, r, lane); return; } r -= I_G;
        if (r < I_G) { p0_transpose_item(w_up, DM, FF, Wgu_t, 2, kscale, r, lane); return; } r -= I_G;
        p0_transpose_item(w_down, FF, DM, Wdn_t, 0, nullptr, r, lane);
    }
    __device__ __forceinline__ void done(const pg8::Unit&) const {
        if (nxt < NITEMS) { convert(nxt, (int)(threadIdx.x & 63)); nxt += ngw; asm volatile("s_waitcnt vmcnt(0)" ::: "memory"); }
    }
    __device__ __forceinline__ void finish() const { while (nxt < NITEMS) { convert(nxt, (int)(threadIdx.x & 63)); nxt += ngw; } }
};

struct Args { const float* in[9]; float* out; unsigned char* ws; int ph_lo, ph_hi; };
__global__ void __launch_bounds__(NWAVES * 64, 2) hybrid_fwd(Args args) {
    extern __shared__ __attribute__((aligned(16))) unsigned char lds[];
    cg::grid_group grid = cg::this_grid();
    const int tid = threadIdx.x, lane = tid & 63, wave = __builtin_amdgcn_readfirstlane(tid >> 6);
    const int G = gridDim.x, bx = blockIdx.x, vcu = (G % 8 == 0) ? (bx % 8) * (G / 8) + bx / 8 : bx;
    const float* x = args.in[0]; const float* norm_mix_w = args.in[1]; const float* w_in = args.in[2]; const float* w_out = args.in[3]; const float* norm_ffn_w = args.in[4];
    const float* w_gate = args.in[5]; const float* w_up = args.in[6]; const float* w_down = args.in[7]; const float* norm_final_w = args.in[8];
    float* out = args.out; unsigned char* ws = args.ws;
    float* SS1 = (float*)(ws + WS_SS); float* SS2 = SS1 + M;
    bf16* Win_t = (bf16*)(ws + WS_WIN); bf16* Wout_t = (bf16*)(ws + WS_WOUT); bf16* Wgu_t = (bf16*)(ws + WS_WGU); bf16* Wdn_t = (bf16*)(ws + WS_WDN);
    bf16* HB = (bf16*)(ws + WS_H); bf16* PROJ = (bf16*)(ws + WS_PROJ); bf16* ACT = (bf16*)(ws + WS_PROJ); bf16* MIXED = (bf16*)(ws + WS_MIXED);
    const int lo = args.ph_lo, hi = args.ph_hi;
#define IN(k) (lo <= (k) && (k) < hi)
    volatile LAS unsigned* MISC = (volatile LAS unsigned*)((LAS unsigned char*)lds + LDS_BYTES - 64);
    if (tid < 16) MISC[tid] = 0u;
    __syncthreads();
    XcdBarrier bar = xcd_barrier_post((unsigned*)(ws + WS_BAR), MISC);
    if (hi > 1000) grid.sync();
#define GRID_BAR(k) do { if (IN(k) && IN((k) + 1)) xcd_barrier(bar); } while (0)
    const int gw = vcu * NWAVES + wave, NGW = G * NWAVES;

    if (IN(0)) {
        constexpr int I_IN = (DM / 64) * (NPROJ / 64);
        for (int it = gw; it < I_IN; it += NGW) p0_transpose_item(w_in, DM, NPROJ, Win_t, 0, nullptr, it, lane);
        f32x4 wmix[8];
#pragma unroll
        for (int j = 0; j < 8; ++j) wmix[j] = ((const f32x4*)norm_mix_w + lane)[64 * j];
        for (int m0 = gw * 4; m0 < M; m0 += NGW * 4) {
            f32x4 v[4][8]; float s[4] = {0.f, 0.f, 0.f, 0.f};
#pragma unroll
            for (int q = 0; q < 4; ++q) { const f32x4* xr = (const f32x4*)(x + (size_t)(m0 + q) * DM) + lane;
#pragma unroll
                for (int j = 0; j < 8; ++j) v[q][j] = xr[64 * j]; }
#pragma unroll
            for (int q = 0; q < 4; ++q)
#pragma unroll
                for (int j = 0; j < 8; ++j) s[q] += (v[q][j].x * v[q][j].x + v[q][j].y * v[q][j].y) + (v[q][j].z * v[q][j].z + v[q][j].w * v[q][j].w);
#pragma unroll
            for (int q = 0; q < 4; ++q) { const float rs = __builtin_amdgcn_rsqf(wave_sum(s[q]) * (1.f / DM) + NORM_EPS);
                v2u* o8 = (v2u*)(HB + (size_t)(m0 + q) * DM) + lane;
#pragma unroll
                for (int j = 0; j < 8; ++j) { const f32x4 w = wmix[j]; v2u o; o.x = cvtpk2(v[q][j].x * rs * w.x, v[q][j].y * rs * w.y); o.y = cvtpk2(v[q][j].z * rs * w.z, v[q][j].w * rs * w.w); o8[64 * j] = o; } }
        }
    }
    GRID_BAR(0);

    if (IN(1)) {
        pg8::Gemm g{HB, Win_t, M, NPROJ, DM}; ConvOrder S; S.init(M, NPROJ, G, bx);
        S.w_out = w_out; S.w_gate = w_gate; S.w_up = w_up; S.w_down = w_down; S.kscale = norm_ffn_w; S.Wout_t = Wout_t; S.Wgu_t = Wgu_t; S.Wdn_t = Wdn_t; S.gw = gw; S.ngw = NGW; S.nxt = gw;
        pg8::EpiProj E{PROJ, NPROJ};
        pg8::gemm_phase<pg8::EpiProj, ConvOrder, true, true>((LAS unsigned char*)lds, g, S, E);
        S.finish();
    }
    GRID_BAR(1);

    if (IN(2)) {
        for (int it = vcu; it < 256; it += G) fa::ret_state_scan(PROJ, HB, it >> 5, (it >> 3) & 3, (it >> 1) & 3, it & 1, (char*)lds);
    }
    GRID_BAR(2);

    if (IN(3)) {
        for (int it = vcu; it < 256; it += G) { const int bh = it >> 2, s = it & 3;
#pragma unroll 1
            for (int ps = 0; ps < 2; ++ps) fa::attn_block(PROJ, MIXED, bh >> 3, bh & 7, ps ? s : 7 - s, (char*)lds); }
        for (int it = vcu; it < 256; it += G) { const int bh = it >> 3, s = it & 7;
#pragma unroll 1
            for (int ps = 0; ps < 2; ++ps) fa::ret_block(PROJ, HB, MIXED, bh >> 2, bh & 3, ps ? s : 15 - s, (char*)lds); }
    }
    GRID_BAR(3);

    if (IN(4)) {
        pg8::Gemm g{MIXED, Wout_t, M, DM, DM}; pg8::StaticOrder S; S.init(M, DM, G, bx);
        pg8::EpiRes<false> E{x, HB, SS1, DM};
        pg8::gemm_phase<pg8::EpiRes<false>, pg8::StaticOrder, true, true>((LAS unsigned char*)lds, g, S, E);
    }
    GRID_BAR(4);

    if (IN(5)) {
        pg8::Gemm g{HB, Wgu_t, M, NGU, DM}; pg8::StaticOrder S; S.init(M, NGU, G, bx);
        pg8::EpiGU E{ACT, FF, SS1, 1.f / DM, NORM_EPS};
        pg8::gemm_phase<pg8::EpiGU, pg8::StaticOrder, true, true>((LAS unsigned char*)lds, g, S, E);
    }
    GRID_BAR(5);

    if (IN(6)) {
        pg8::Gemm g{ACT, Wdn_t, M, DM, FF}; pg8::StaticOrder S; S.init(M, DM, G, bx);
        pg8::EpiRes<true> E{HB, MIXED, SS2, DM};
        pg8::gemm_phase<pg8::EpiRes<true>, pg8::StaticOrder, true, true>((LAS unsigned char*)lds, g, S, E);
    }
    GRID_BAR(6);

    if (IN(7)) {
        f32x4 wfin[8];
#pragma unroll
        for (int j = 0; j < 8; ++j) wfin[j] = ((const f32x4*)norm_final_w + lane)[64 * j];
        for (int m0 = gw * 4; m0 < M; m0 += NGW * 4) {
            v2u r[4][8]; float rs[4];
#pragma unroll
            for (int q = 0; q < 4; ++q) { const v2u* xr = (const v2u*)(MIXED + (size_t)(m0 + q) * DM) + lane; rs[q] = __builtin_amdgcn_rsqf(SS2[m0 + q] * (1.f / DM) + NORM_EPS);
#pragma unroll
                for (int j = 0; j < 8; ++j) r[q][j] = xr[64 * j]; }
#pragma unroll
            for (int q = 0; q < 4; ++q) { f32x4* orow = (f32x4*)(out + (size_t)(m0 + q) * DM) + lane;
#pragma unroll
                for (int j = 0; j < 8; ++j) { const f32x4 w = wfin[j]; const float s = rs[q];
                    orow[64 * j] = (f32x4){__uint_as_float(r[q][j].x << 16) * s * w.x, __uint_as_float(r[q][j].x & 0xffff0000u) * s * w.y, __uint_as_float(r[q][j].y << 16) * s * w.z, __uint_as_float(r[q][j].y & 0xffff0000u) * s * w.w}; } }
        }
    }
#undef IN
#undef GRID_BAR
}

extern "C" void kernel_launch(void* const* d_in, const int* in_sizes, int n_in, void* d_out, int out_size, void* d_ws, size_t ws_size, hipStream_t stream) {
    static int grid = 0;
    if (grid == 0) {
        if (n_in != 9 || in_sizes[0] != M * DM || out_size != M * DM || ws_size < WS_END) { fprintf(stderr, "kernel_launch: unexpected shapes (n_in %d, in0 %d, out %d, ws %zu)\n", n_in, n_in > 0 ? in_sizes[0] : -1, out_size, ws_size); grid = -1; return; }
        int dev = 0, cus = 0, per_cu = 0;
        (void)hipGetDevice(&dev); (void)hipDeviceGetAttribute(&cus, hipDeviceAttributeMultiprocessorCount, dev);
        if (hipFuncSetAttribute((const void*)hybrid_fwd, hipFuncAttributeMaxDynamicSharedMemorySize, LDS_BYTES) != hipSuccess) { fprintf(stderr, "kernel_launch: hipFuncSetAttribute failed\n"); grid = -1; return; }
        if (hipOccupancyMaxActiveBlocksPerMultiprocessor(&per_cu, (const void*)hybrid_fwd, NWAVES * 64, LDS_BYTES) != hipSuccess || per_cu < 1) { fprintf(stderr, "kernel_launch: occupancy query says %d\n", per_cu); per_cu = 1; }
        (void)hipGetLastError();
        grid = cus * per_cu;
    }
    if (grid < 0) return;
    if (hipMemsetAsync((char*)d_ws + WS_SS, 0, CTL_ZERO_BYTES, stream) != hipSuccess) { fprintf(stderr, "kernel_launch: hipMemsetAsync failed\n"); return; }
    Args a{};
    for (int i = 0; i < 9; ++i) a.in[i] = (const float*)d_in[i];
    a.out = (float*)d_out; a.ws = (unsigned char*)d_ws;
#if MK_N_LAUNCHES == 1
    a.ph_lo = 0; a.ph_hi = NPHASE;
    void* kargs[] = {&a};
    const hipError_t le = hipLaunchCooperativeKernel((const void*)hybrid_fwd, dim3(grid), dim3(NWAVES * 64), kargs, LDS_BYTES, stream);
    if (le != hipSuccess) fprintf(stderr, "kernel_launch: cooperative launch failed: %s (grid %d)\n", hipGetErrorString(le), grid);
#else
    for (int p = 0; p < NPHASE; ++p) { a.ph_lo = p; a.ph_hi = p + 1; hipLaunchKernelGGL(hybrid_fwd, dim3(grid), dim3(NWAVES * 64), LDS_BYTES, stream, a); }
#endif
}
```

```cpp
#include <hip/hip_runtime.h>
#include <hip/hip_cooperative_groups.h>
#include <cstdio>
#include <cstdint>
namespace cg = cooperative_groups;
namespace pg8 {
#define PG8_LAS __attribute__((address_space(3)))
typedef unsigned short bf16_t;
typedef short bf16x8 __attribute__((ext_vector_type(8)));
typedef float f32x4 __attribute__((ext_vector_type(4)));
typedef unsigned u32x4 __attribute__((ext_vector_type(4)));
constexpr int BM = 256, BK = 64, HALF = 128, HTB = HALF * BK * 2  , STAGE_BYTES = 8 * HTB, NXCD = 8, WGM = 4;

__host__ __device__ __forceinline__ int lds_byte(int r, int c) { const int st = (r >> 4) * 2 + (c >> 5), rr = r & 15, cc = c & 31, ob = rr * 64 + cc * 2; return st * 1024 + (ob ^ (((ob >> 9) & 1) << 5)); }
__host__ __device__ __forceinline__ void stage_rc(int b, int& R, int& C) { const int st = b / 1024, sb = b % 1024, swz = sb ^ (((sb >> 9) & 1) << 5); R = (st >> 1) * 16 + swz / 64; C = (st & 1) * 32 + (swz % 64) / 2; }
__host__ __device__ __forceinline__ int perm32(int rho) { const int n = rho >> 4, i = rho & 15; return 8 * (i >> 2) + 4 * n + (i & 3); }

struct Unit { int pm, pn; };
struct Gemm { const bf16_t* A; const bf16_t* Bt; int M, N, K; };

struct StaticOrder {
    int nM, nN, nwg, G, c, wgm;
    __host__ __device__ void init(int M, int N, int G_, int c_, int wgm_ = WGM) { nM = M / BM; nN = N / BM; nwg = nM * nN; G = G_; c = c_; wgm = wgm_; }
    __host__ __device__ bool next(int i, Unit& u) const {
        const long L = (long)i * G + c; if (L >= nwg) return false;
        int wgid = (int)L; { const int q = nwg / NXCD, r = nwg % NXCD, xcd = wgid % NXCD, off = wgid / NXCD; wgid = (xcd < r ? xcd * (q + 1) : r * (q + 1) + (xcd - r) * q) + off; }
        const int nig = wgm * nN, gid = wgid / nig, fm = gid * wgm, gsz = (nM - fm) < wgm ? (nM - fm) : wgm;
        u.pm = fm + ((wgid % nig) % gsz); u.pn = (wgid % nig) / gsz; return true;
    }
    __device__ __forceinline__ void a_ready(const Unit&) const {}
    __device__ __forceinline__ void done(const Unit&) const {}
};

__device__ __forceinline__ unsigned cvt_pk_bf16(float lo, float hi) { unsigned r; asm volatile("v_cvt_pk_bf16_f32 %0, %1, %2" : "=v"(r) : "v"(lo), "v"(hi)); return r; }
typedef unsigned u32x2 __attribute__((ext_vector_type(2)));

struct EpiProj {
    static constexpr bool PERM = true, AFTER_DRAIN = false;
    bf16_t* O; int ldc;
    __device__ __forceinline__ void operator()(const f32x4 (&acc)[2][2][4][2], const Unit& u, int wr, int wc, int fr, int fq) const {
        const int row0 = u.pm * BM + wr * 64 + fr, col0 = u.pn * BM + wc * 32 + 8 * fq;
        const int mode = (u.pn >= 12 && u.pn < 16) ? 1 : ((u.pn >= 16 && u.pn < 20) ? 2 : 0);
        float lg = 0.f; if (mode) { const int hd = (u.pn - 12) & 3; lg = __log2f(1.0f - __builtin_amdgcn_exp2f(-5.0f - (float)hd)); }
#pragma unroll
        for (int ai = 0; ai < 2; ++ai)
#pragma unroll
            for (int m = 0; m < 4; ++m) { const int row = row0 + ai * HALF + m * 16; bf16_t* rowp = O + (size_t)row * ldc + col0;
                float sc = 1.f;
                if (mode) { const float e = (float)((row & 2047) - 1024) * lg; sc = (mode == 1) ? __builtin_amdgcn_exp2f(e) : __builtin_amdgcn_exp2f(-e) * 0.0625f; }
#pragma unroll
                for (int bj = 0; bj < 2; ++bj) { const f32x4 v0 = acc[ai][bj][m][0] * sc, v1 = acc[ai][bj][m][1] * sc;
                    u32x4 w; w.x = cvt_pk_bf16(v0[0], v0[1]); w.y = cvt_pk_bf16(v0[2], v0[3]); w.z = cvt_pk_bf16(v1[0], v1[1]); w.w = cvt_pk_bf16(v1[2], v1[3]);
                    *(u32x4*)(rowp + bj * HALF) = w; } }
    }
};
template <bool BASE_BF16> struct EpiRes {
    static constexpr bool PERM = true, AFTER_DRAIN = false;
    const void* base; bf16_t* out; float* ss; int ldc;
    __device__ __forceinline__ void tail(const f32x4& b0, const f32x4& b1, const f32x4& a0, const f32x4& a1, bf16_t* dst, float& s) const {
        const f32x4 o0 = b0 + a0, o1 = b1 + a1;
        s += ((o0[0] * o0[0] + o0[1] * o0[1]) + (o0[2] * o0[2] + o0[3] * o0[3])) + ((o1[0] * o1[0] + o1[1] * o1[1]) + (o1[2] * o1[2] + o1[3] * o1[3]));
        u32x4 w; w.x = cvt_pk_bf16(o0[0], o0[1]); w.y = cvt_pk_bf16(o0[2], o0[3]); w.z = cvt_pk_bf16(o1[0], o1[1]); w.w = cvt_pk_bf16(o1[2], o1[3]);
        *(u32x4*)dst = w;
    }
    __device__ __forceinline__ void operator()(const f32x4 (&acc)[2][2][4][2], const Unit& u, int wr, int wc, int fr, int fq) const {
        const int col0 = u.pn * BM + wc * 32 + 8 * fq;
        if constexpr (BASE_BF16) {
            u32x4 raw[2][4][2];
#pragma unroll
            for (int ai = 0; ai < 2; ++ai)
#pragma unroll
                for (int m = 0; m < 4; ++m) { const int row = u.pm * BM + ai * HALF + wr * 64 + m * 16 + fr; const size_t off = (size_t)row * ldc + col0;
#pragma unroll
                    for (int bj = 0; bj < 2; ++bj) raw[ai][m][bj] = *(const u32x4*)((const bf16_t*)base + off + bj * HALF); }
            asm volatile("" ::: "memory");
#pragma unroll
            for (int ai = 0; ai < 2; ++ai)
#pragma unroll
                for (int m = 0; m < 4; ++m) { const int row = u.pm * BM + ai * HALF + wr * 64 + m * 16 + fr; const size_t off = (size_t)row * ldc + col0; float s = 0.f;
#pragma unroll
                    for (int bj = 0; bj < 2; ++bj) { const u32x4 r = raw[ai][m][bj];
                        const f32x4 b0 = {__uint_as_float(r.x << 16), __uint_as_float(r.x & 0xffff0000u), __uint_as_float(r.y << 16), __uint_as_float(r.y & 0xffff0000u)};
                        const f32x4 b1 = {__uint_as_float(r.z << 16), __uint_as_float(r.z & 0xffff0000u), __uint_as_float(r.w << 16), __uint_as_float(r.w & 0xffff0000u)};
                        tail(b0, b1, acc[ai][bj][m][0], acc[ai][bj][m][1], out + off + bj * HALF, s); }
                    s += __shfl_xor(s, 16); s += __shfl_xor(s, 32);
                    if (fq == 0) atomicAdd(ss + row, s); }
        } else {
#pragma unroll
            for (int ai = 0; ai < 2; ++ai) {
                f32x4 pb0[4][2], pb1[4][2];
#pragma unroll
                for (int m = 0; m < 4; ++m) { const int row = u.pm * BM + ai * HALF + wr * 64 + m * 16 + fr; const size_t off = (size_t)row * ldc + col0;
#pragma unroll
                    for (int bj = 0; bj < 2; ++bj) { const float* bp = (const float*)base + off + bj * HALF; pb0[m][bj] = *(const f32x4*)bp; pb1[m][bj] = *(const f32x4*)(bp + 4); } }
                asm volatile("" ::: "memory");
#pragma unroll
                for (int m = 0; m < 4; ++m) { const int row = u.pm * BM + ai * HALF + wr * 64 + m * 16 + fr; const size_t off = (size_t)row * ldc + col0; float s = 0.f;
#pragma unroll
                    for (int bj = 0; bj < 2; ++bj) tail(pb0[m][bj], pb1[m][bj], acc[ai][bj][m][0], acc[ai][bj][m][1], out + off + bj * HALF, s);
                    s += __shfl_xor(s, 16); s += __shfl_xor(s, 32);
                    if (fq == 0) atomicAdd(ss + row, s); }
                asm volatile("" ::: "memory");
            }
        }
    }
};
struct EpiGU {
    static constexpr bool PERM = true, AFTER_DRAIN = false;
    bf16_t* O; int ldc; const float* ss; float inv_n, eps;
    __device__ __forceinline__ void operator()(const f32x4 (&acc)[2][2][4][2], const Unit& u, int wr, int wc, int fr, int fq) const {
        const int row0 = u.pm * BM + wr * 64 + fr, col0 = u.pn * HALF + wc * 32 + 8 * fq;
        float rsv[2][4];
#pragma unroll
        for (int ai = 0; ai < 2; ++ai)
#pragma unroll
            for (int m = 0; m < 4; ++m) rsv[ai][m] = ss[row0 + ai * HALF + m * 16];
        asm volatile("" ::: "memory");
#pragma unroll
        for (int ai = 0; ai < 2; ++ai)
#pragma unroll
            for (int m = 0; m < 4; ++m) { const int row = row0 + ai * HALF + m * 16; const float rs = __builtin_amdgcn_rsqf(rsv[ai][m] * inv_n + eps);
                float a[8];
#pragma unroll
                for (int n = 0; n < 2; ++n)
#pragma unroll
                    for (int i = 0; i < 4; ++i) { const float g = acc[ai][0][m][n][i] * rs, up = acc[ai][1][m][n][i] * rs;
                        a[n * 4 + i] = g * __builtin_amdgcn_rcpf(1.0f + __builtin_amdgcn_exp2f(-1.4426950408889634f * g)) * up; }
                u32x4 w; w.x = cvt_pk_bf16(a[0], a[1]); w.y = cvt_pk_bf16(a[2], a[3]); w.z = cvt_pk_bf16(a[4], a[5]); w.w = cvt_pk_bf16(a[6], a[7]);
                *(u32x4*)(O + (size_t)row * ldc + col0) = w; }
    }
};

template <class Epi, class Sched, bool ALIGN_EPI = false, bool SP2 = false>
__device__ __forceinline__ void gemm_phase(PG8_LAS unsigned char* lds, const Gemm g, const Sched& S, const Epi& E) {
    int tid_ = threadIdx.x; asm volatile("" : "+v"(tid_));
    const int tid = tid_, wid = __builtin_amdgcn_readfirstlane(tid >> 6), lane = tid & 63, wr = wid >> 2, wc = wid & 3, fr = lane & 15, fq = lane >> 4;
    const int K = g.K, nt = K / BK;
    unsigned voffA[2], voffB[2];
#pragma unroll
    for (int i = 0; i < 2; ++i) { int R, C; stage_rc(tid * 16 + i * 8192, R, C); const int Rb = Epi::PERM ? ((R & ~31) + perm32(R & 31)) : R;
        voffA[i] = (unsigned)(R * K + C) * 2u; voffB[i] = (unsigned)(Rb * K + C) * 2u; }
    const size_t kstep = (size_t)(BK * 2);
    const size_t hstep = (size_t)HALF * K * 2;
    const size_t tstep = 2 * hstep;
    const unsigned ldsw = (unsigned)wid * 1024u;
    const int aoff = lds_byte(wr * 64 + fr, fq * 8), boff = lds_byte(wc * 32 + fr, fq * 8);
#define PG8_SA(b, h) (((b) * 2 + (h)) * HTB)
#define PG8_SB(b, h) ((4 + (b) * 2 + (h)) * HTB)
#define PG8_STAGE(bufoff, gbase, voff) do { _Pragma("unroll") for (int _i = 0; _i < 2; ++_i) \
        __builtin_amdgcn_global_load_lds((const unsigned*)((const char*)(gbase) + (voff)[_i]), (PG8_LAS unsigned*)(lds + (bufoff) + ldsw + _i * 8192), 16, 0, 0); } while (0)
#define PG8_LDA(dst, b, h) do { _Pragma("unroll") for (int m = 0; m < 4; ++m) _Pragma("unroll") for (int k = 0; k < 2; ++k) dst[m][k] = *(const PG8_LAS bf16x8*)(lds + PG8_SA(b, h) + aoff + m * 2048 + k * 1024); } while (0)
#define PG8_LDB(dst, b, h) do { _Pragma("unroll") for (int n = 0; n < 2; ++n) _Pragma("unroll") for (int k = 0; k < 2; ++k) dst[n][k] = *(const PG8_LAS bf16x8*)(lds + PG8_SB(b, h) + boff + n * 2048 + k * 1024); } while (0)
#define PG8_MMA(ai, bj, At, Bt) do { __builtin_amdgcn_s_setprio(1); _Pragma("unroll") for (int m = 0; m < 4; ++m) _Pragma("unroll") for (int n = 0; n < 2; ++n) _Pragma("unroll") for (int k = 0; k < 2; ++k) \
        acc[ai][bj][m][n] = __builtin_amdgcn_mfma_f32_16x16x32_bf16(Bt[n][k], At[m][k], acc[ai][bj][m][n], 0, 0, 0); __builtin_amdgcn_s_setprio(0); } while (0)
#define PG8_WAIT_V(n) asm volatile("s_waitcnt vmcnt(" #n ")" ::: "memory")
#define PG8_WAIT_L(n) asm volatile("s_waitcnt lgkmcnt(" #n ")" ::: "memory")
#define PG8_BAR __builtin_amdgcn_s_barrier()
#define PG8_SCHED __builtin_amdgcn_sched_barrier(0)
    Unit cur, nxt; int ui = 0;
    if (!S.next(0, cur)) return;
    f32x4 acc[2][2][4][2];
#pragma unroll
    for (int a = 0; a < 2; ++a)
#pragma unroll
        for (int b = 0; b < 2; ++b)
#pragma unroll
            for (int m = 0; m < 4; ++m)
#pragma unroll
                for (int n = 0; n < 2; ++n) acc[a][b][m][n] = (f32x4){0.f, 0.f, 0.f, 0.f};
    bf16x8 At[4][2], B0[2][2], B1[2][2];
    const char* cA = (const char*)g.A + (size_t)cur.pm * tstep; const char* cB = (const char*)g.Bt + (size_t)cur.pn * tstep;
    S.a_ready(cur);
    if constexpr (SP2) {
        PG8_STAGE(PG8_SB(0, 0), cB, voffB); PG8_STAGE(PG8_SB(0, 1), cB + hstep, voffB); PG8_STAGE(PG8_SA(0, 0), cA, voffA); PG8_STAGE(PG8_SA(0, 1), cA + hstep, voffA);
        if (wr == 1) PG8_BAR;
        PG8_WAIT_V(2); PG8_BAR;
        PG8_STAGE(PG8_SB(1, 0), cB + kstep, voffB); PG8_STAGE(PG8_SA(1, 0), cA + kstep, voffA); PG8_STAGE(PG8_SB(1, 1), cB + hstep + kstep, voffB);
        PG8_WAIT_V(6); PG8_BAR;
    } else {
        PG8_STAGE(PG8_SB(0, 0), cB, voffB); PG8_STAGE(PG8_SA(0, 0), cA, voffA); PG8_STAGE(PG8_SB(0, 1), cB + hstep, voffB); PG8_STAGE(PG8_SA(0, 1), cA + hstep, voffA);
        if (wr == 1) PG8_BAR;
        PG8_WAIT_V(4); PG8_BAR;
        PG8_STAGE(PG8_SB(1, 0), cB + kstep, voffB); PG8_STAGE(PG8_SA(1, 0), cA + kstep, voffA); PG8_STAGE(PG8_SB(1, 1), cB + hstep + kstep, voffB);
        PG8_WAIT_V(6); PG8_BAR;
    }
    for (;;) {
        const bool has_next = S.next(ui + 1, nxt);
        const char* nA = has_next ? (const char*)g.A + (size_t)nxt.pm * tstep : cA; const char* nB = has_next ? (const char*)g.Bt + (size_t)nxt.pn * tstep : cB;
        for (int t = 0; t < nt; t += 2) {
            const bool last = (t == nt - 2);
            const char* a1 = cA + (size_t)(t + 1) * kstep;
            const char* a2 = last ? nA : cA + (size_t)(t + 2) * kstep; const char* b2 = last ? nB : cB + (size_t)(t + 2) * kstep;
            const char* a3 = a2 + kstep; const char* b3 = b2 + kstep;
            if (last && has_next) S.a_ready(nxt);
            if constexpr (SP2) {
            PG8_LDB(B0, 0, 0); PG8_LDB(B1, 0, 1); PG8_SCHED; PG8_LDA(At, 0, 0); PG8_STAGE(PG8_SA(1, 1), a1 + hstep, voffA);
            PG8_WAIT_V(8); PG8_WAIT_L(0); PG8_BAR; PG8_MMA(0, 0, At, B0); PG8_MMA(0, 1, At, B1); PG8_BAR; PG8_SCHED;
            PG8_LDA(At, 0, 1); PG8_STAGE(PG8_SB(0, 0), b2, voffB); PG8_STAGE(PG8_SB(0, 1), b2 + hstep, voffB); PG8_STAGE(PG8_SA(0, 0), a2, voffA);
            PG8_WAIT_V(8); PG8_WAIT_L(0); PG8_BAR; PG8_MMA(1, 0, At, B0); PG8_MMA(1, 1, At, B1); PG8_BAR; PG8_SCHED;
            PG8_LDB(B0, 1, 0); PG8_LDB(B1, 1, 1); PG8_SCHED; PG8_LDA(At, 1, 0); PG8_STAGE(PG8_SA(0, 1), a2 + hstep, voffA);
            PG8_WAIT_V(8); PG8_WAIT_L(0); PG8_BAR; PG8_MMA(0, 0, At, B0); PG8_MMA(0, 1, At, B1); PG8_BAR; PG8_SCHED;
            PG8_LDA(At, 1, 1); PG8_STAGE(PG8_SB(1, 0), b3, voffB); PG8_STAGE(PG8_SB(1, 1), b3 + hstep, voffB); PG8_STAGE(PG8_SA(1, 0), a3, voffA);
            PG8_WAIT_V(8); PG8_WAIT_L(0); PG8_BAR; PG8_MMA(1, 0, At, B0); PG8_MMA(1, 1, At, B1); PG8_BAR; PG8_SCHED;
            } else {
            PG8_LDB(B0, 0, 0); PG8_SCHED; PG8_LDA(At, 0, 0); PG8_STAGE(PG8_SA(1, 1), a1 + hstep, voffA);
            PG8_WAIT_L(8); PG8_BAR; PG8_WAIT_L(0); PG8_MMA(0, 0, At, B0); PG8_BAR; PG8_SCHED;
            PG8_LDB(B1, 0, 1); PG8_STAGE(PG8_SB(0, 0), b2, voffB);
            PG8_BAR; PG8_WAIT_L(0); PG8_MMA(0, 1, At, B1); PG8_BAR;
            PG8_LDA(At, 0, 1); PG8_STAGE(PG8_SA(0, 0), a2, voffA);
            PG8_BAR; PG8_WAIT_L(0); PG8_MMA(1, 0, At, B0); PG8_BAR; PG8_SCHED;
            PG8_STAGE(PG8_SB(0, 1), b2 + hstep, voffB);
            PG8_WAIT_V(6); PG8_BAR; PG8_MMA(1, 1, At, B1); PG8_BAR;
            PG8_LDB(B0, 1, 0); PG8_SCHED; PG8_LDA(At, 1, 0); PG8_STAGE(PG8_SA(0, 1), a2 + hstep, voffA);
            PG8_WAIT_L(8); PG8_BAR; PG8_WAIT_L(0); PG8_MMA(0, 0, At, B0); PG8_BAR; PG8_SCHED;
            PG8_LDB(B1, 1, 1); PG8_STAGE(PG8_SB(1, 0), b3, voffB);
            PG8_BAR; PG8_WAIT_L(0); PG8_MMA(0, 1, At, B1); PG8_BAR;
            PG8_LDA(At, 1, 1); PG8_STAGE(PG8_SA(1, 0), a3, voffA);
            PG8_BAR; PG8_WAIT_L(0); PG8_MMA(1, 0, At, B0); PG8_BAR; PG8_SCHED;
            PG8_STAGE(PG8_SB(1, 1), b3 + hstep, voffB);
            PG8_WAIT_V(6); PG8_BAR; PG8_MMA(1, 1, At, B1); PG8_BAR;
            }
        }
        if constexpr (ALIGN_EPI) { if (wr == 0) PG8_BAR; }
        if constexpr (!Epi::AFTER_DRAIN) { E(acc, cur, wr, wc, fr, fq); S.done(cur); }
        if (!has_next) break;
#pragma unroll
        for (int a = 0; a < 2; ++a)
#pragma unroll
            for (int b = 0; b < 2; ++b)
#pragma unroll
                for (int m = 0; m < 4; ++m)
#pragma unroll
                    for (int n = 0; n < 2; ++n) acc[a][b][m][n] = (f32x4){0.f, 0.f, 0.f, 0.f};
        cur = nxt; cA = nA; cB = nB; ++ui;
        if constexpr (ALIGN_EPI) { if (wr == 1) PG8_BAR; }
    }
    PG8_WAIT_V(0);
    if constexpr (!ALIGN_EPI) { if (wr == 0) PG8_BAR; }
    PG8_BAR;
    if constexpr (Epi::AFTER_DRAIN) { E.fused(acc, cur, wr, wc, fr, fq, lds, wid, lane); S.done(cur); }
#undef PG8_SA
#undef PG8_SB
#undef PG8_STAGE
#undef PG8_LDA
#undef PG8_LDB
#undef PG8_MMA
#undef PG8_WAIT_V
#undef PG8_WAIT_L
#undef PG8_BAR
#undef PG8_SCHED
}
}

namespace fa {
typedef unsigned short bf16_t;
typedef short bf16x8 __attribute__((ext_vector_type(8)));
typedef short s16x4 __attribute__((ext_vector_type(4)));
typedef float f32x16 __attribute__((ext_vector_type(16)));
typedef float f32x4 __attribute__((ext_vector_type(4)));
typedef unsigned u32x4 __attribute__((ext_vector_type(4)));
constexpr int LDQ = 7168, LDO = 2048, SEQ = 2048;
constexpr float SCALE = 0.08838834764831845f;
constexpr float LOG2E = 1.4426950408889634f;
#define SBAR() __builtin_amdgcn_sched_barrier(0)
#define FA_LAS __attribute__((address_space(3)))
template <int NCB> __device__ __forceinline__ int v_st(int k, int c) { const int kk = (k & ~0xC) | ((k & 4) << 1) | ((k & 8) >> 1); return ((kk >> 3) * NCB + (c >> 5)) * 512 + ((kk & 7) * 32 + (c & 31)) * 2; }
__device__ __forceinline__ int v_rd_base(int lane) { return ((lane & 3) << 3) | (((lane >> 2) & 3) << 6) | (((lane >> 4) & 1) << 5) | (((lane >> 5) & 1) << 8); }
__device__ __forceinline__ int crow(int r, int hi) { return (r & 3) + 8 * (r >> 2) + 4 * hi; }
__device__ __forceinline__ unsigned cvtpk(float lo, float hi) { unsigned r; asm volatile("v_cvt_pk_bf16_f32 %0, %1, %2" : "=v"(r) : "v"(lo), "v"(hi)); return r; }
__device__ __forceinline__ float bf2f(bf16_t v) { return __uint_as_float(((unsigned)v) << 16); }

template <int CLS> __device__ __forceinline__ void bias_tile(f32x16& p0, f32x16& p1, int dq, float slr, int dq15, int dq3) {
    const float NEG = -__builtin_inff(); const float L2R = 0.6931471805599453f / SCALE, L3R = 1.0986122886681098f / SCALE;
#pragma unroll
    for (int r = 0; r < 16; ++r) {
#pragma unroll
        for (int hf = 0; hf < 2; ++hf) {
            const int C = (r & 3) + 8 * (r >> 2) + 32 * hf;
            float v = hf ? p1[r] : p0[r];
            v = __builtin_fmaf(slr, (float)C, v);
            const bool m16 = dq15 == (C & 15), m4 = dq3 == (C & 3);
            if (CLS == 2) { v = m16 ? v : NEG; }
            else if (CLS == 1) { const float v2 = v + L2R; v = m16 ? v2 : v; v = m4 ? v : NEG; }
            else if (CLS == 3 || CLS == 4) { float bb = m4 ? L2R : 0.f; bb = m16 ? L3R : bb; v += bb; if (CLS == 4) v = (dq >= C) ? v : NEG; }
            else if (CLS == 5) { const bool n1 = dq <= C + 128; const float b16 = n1 ? L3R : L2R, b4 = n1 ? L2R : 0.f, b1 = n1 ? 0.f : NEG; v += m16 ? b16 : (m4 ? b4 : b1); }
            else { const bool n5 = dq <= C + 512; const float b16 = n5 ? L2R : 0.f, b4 = n5 ? 0.f : NEG; v += m16 ? b16 : (m4 ? b4 : NEG); }
            if (hf) p1[r] = v; else p0[r] = v;
        }
    }
}
constexpr float THR = 8.f;
__device__ __forceinline__ void partialSM(f32x16& p0, f32x16& p1, float& m_reg, float& mn, float& alpha) {
    float pmax = p0[0];
#pragma unroll
    for (int r = 1; r < 16; ++r) pmax = fmaxf(pmax, p0[r]);
#pragma unroll
    for (int r = 0; r < 16; ++r) pmax = fmaxf(pmax, p1[r]);
    { auto rr = __builtin_amdgcn_permlane32_swap(__float_as_uint(pmax), __float_as_uint(pmax), false, false);
      pmax = fmaxf(__uint_as_float(rr[0]), __uint_as_float(rr[1])); }
    constexpr float C2 = LOG2E * SCALE;
    if (__builtin_expect(__all((pmax - m_reg) * SCALE <= THR), 1)) { mn = m_reg; alpha = 1.f; }
    else { mn = fmaxf(m_reg, pmax); alpha = __builtin_amdgcn_exp2f((m_reg - mn) * C2); m_reg = mn; }
    const float mnL = -mn * C2;
#pragma unroll
    for (int r = 0; r < 16; ++r) p0[r] = __builtin_fmaf(p0[r], C2, mnL);
#pragma unroll
    for (int r = 0; r < 16; ++r) p1[r] = __builtin_fmaf(p1[r], C2, mnL);
#pragma unroll
    for (int r = 0; r < 16; ++r) p0[r] = __builtin_amdgcn_exp2f(p0[r]);
#pragma unroll
    for (int r = 0; r < 16; ++r) p1[r] = __builtin_amdgcn_exp2f(p1[r]);
}
#define FA_PK4(P, B_, OUT) do { unsigned a0 = cvtpk(P[B_+0], P[B_+1]), a1 = cvtpk(P[B_+2], P[B_+3]);                          \
        unsigned b0 = cvtpk(P[B_+4], P[B_+5]), b1 = cvtpk(P[B_+6], P[B_+7]);                                             \
        auto r0 = __builtin_amdgcn_permlane32_swap(a0, b0, false, false); auto r1 = __builtin_amdgcn_permlane32_swap(a1, b1, false, false); \
        u32x4 w = {r0[0], r1[0], r0[1], r1[1]}; OUT = *reinterpret_cast<bf16x8*>(&w); } while (0)
__device__ __forceinline__ void pack_p(const f32x16& p0, const f32x16& p1, bf16x8& pa0, bf16x8& pa1, bf16x8& pa2, bf16x8& pa3) {
    FA_PK4(p0, 0, pa0); FA_PK4(p0, 8, pa1); FA_PK4(p1, 0, pa2); FA_PK4(p1, 8, pa3);
}
__device__ __forceinline__ void finishSM(f32x16& p0, f32x16& p1, float alpha, float& l_reg, bf16x8& pa0, bf16x8& pa1, bf16x8& pa2, bf16x8& pa3) {
    float ps = 0;
#pragma unroll
    for (int r = 0; r < 16; ++r) ps += p0[r];
#pragma unroll
    for (int r = 0; r < 16; ++r) ps += p1[r];
    { auto rr = __builtin_amdgcn_permlane32_swap(__float_as_uint(ps), __float_as_uint(ps), false, false);
      ps = __uint_as_float(rr[0]) + __uint_as_float(rr[1]); }
    l_reg = l_reg * alpha + ps;
    pack_p(p0, p1, pa0, pa1, pa2, pa3);
}
template <int NF, int RB>
__device__ __forceinline__ void qkt(f32x16& p0, f32x16& p1, const char* Kt, int r32, int hi, const bf16x8* qr, float init) {
#pragma unroll
    for (int r = 0; r < 16; ++r) { p0[r] = init; p1[r] = init; }
    const char* kb[4];
#pragma unroll
    for (int dd = 0; dd < 4; ++dd) kb[dd] = Kt + r32 * RB + (((dd * 16 + hi * 8) * 2) ^ ((r32 & 7) << 4));
#pragma unroll
    for (int d0 = 0; d0 < NF; ++d0) { const char* a = kb[d0 & 3] + (d0 >> 2) * 128;
        bf16x8 b0 = *reinterpret_cast<const bf16x8*>(a);
        bf16x8 b1 = *reinterpret_cast<const bf16x8*>(a + 32 * RB);
        p0 = __builtin_amdgcn_mfma_f32_32x32x16_bf16(b0, qr[d0], p0, 0, 0, 0);
        p1 = __builtin_amdgcn_mfma_f32_32x32x16_bf16(b1, qr[d0], p1, 0, 0, 0); }
}
template <int NF, int RB>
__device__ __forceinline__ void qkt1(f32x16& p, const char* Kt, int r32, int hi, const bf16x8* qr) {
#pragma unroll
    for (int r = 0; r < 16; ++r) p[r] = 0.f;
    const char* kb[4];
#pragma unroll
    for (int dd = 0; dd < 4; ++dd) kb[dd] = Kt + r32 * RB + (((dd * 16 + hi * 8) * 2) ^ ((r32 & 7) << 4));
#pragma unroll
    for (int d0 = 0; d0 < NF; ++d0) { const bf16x8 b0 = *reinterpret_cast<const bf16x8*>(kb[d0 & 3] + (d0 >> 2) * 128);
        p = __builtin_amdgcn_mfma_f32_32x32x16_bf16(b0, qr[d0], p, 0, 0, 0); }
}
template <int KS, int HF>
__device__ __forceinline__ void pv_tile(f32x16* o, int vb, bf16x8 pa0, bf16x8 pa1, bf16x8 pa2, bf16x8 pa3) {
#define FA_TRRD(dst, off) asm volatile("ds_read_b64_tr_b16 %0, %1 offset:%2" : "=&v"(dst) : "v"(vb), "i"(off) : "memory")
#define FA_PV_D0(d0) do { s16x4 l0, l1, l2, l3, h0, h1, h2, h3; constexpr int b_ = (d0) * 512; \
        FA_TRRD(l0, b_); FA_TRRD(h0, b_ + HF); FA_TRRD(l1, b_ + KS); FA_TRRD(h1, b_ + KS + HF); FA_TRRD(l2, b_ + 2 * KS); FA_TRRD(h2, b_ + 2 * KS + HF); FA_TRRD(l3, b_ + 3 * KS); FA_TRRD(h3, b_ + 3 * KS + HF); \
        asm volatile("s_waitcnt lgkmcnt(0)" ::: "memory"); SBAR();   \
        o[d0] = __builtin_amdgcn_mfma_f32_32x32x16_bf16(pa0, (bf16x8){l0[0], l0[1], l0[2], l0[3], h0[0], h0[1], h0[2], h0[3]}, o[d0], 0, 0, 0);   \
        o[d0] = __builtin_amdgcn_mfma_f32_32x32x16_bf16(pa1, (bf16x8){l1[0], l1[1], l1[2], l1[3], h1[0], h1[1], h1[2], h1[3]}, o[d0], 0, 0, 0);   \
        o[d0] = __builtin_amdgcn_mfma_f32_32x32x16_bf16(pa2, (bf16x8){l2[0], l2[1], l2[2], l2[3], h2[0], h2[1], h2[2], h2[3]}, o[d0], 0, 0, 0);   \
        o[d0] = __builtin_amdgcn_mfma_f32_32x32x16_bf16(pa3, (bf16x8){l3[0], l3[1], l3[2], l3[3], h3[0], h3[1], h3[2], h3[3]}, o[d0], 0, 0, 0); } while (0)
    FA_PV_D0(0); FA_PV_D0(1); FA_PV_D0(2); FA_PV_D0(3);
#undef FA_PV_D0
#undef FA_TRRD
}

__device__ __forceinline__ void attn_block(const bf16_t* __restrict__ proj, bf16_t* __restrict__ mixed, int b, int h, int qb, char* lds) {
    int tid_ = threadIdx.x; asm volatile("" : "+v"(tid_));
    const int tid = tid_, wid = __builtin_amdgcn_readfirstlane(tid >> 6), lane = tid & 63, r32 = lane & 31, hi = lane >> 5;
    constexpr int SHM = 16384;
    char* V_lds = lds; char* K_lds = lds + 2 * SHM;
    float* wsf = (float*)(lds + 65536) + wid * 64; float* li_l = wsf; float* al_l = wsf + 32;
    const bf16_t* Qp = proj + (size_t)(b * SEQ + qb * 256) * LDQ + h * 128;
    const bf16_t* Kp = proj + (size_t)(b * SEQ) * LDQ + 1024 + h * 128;
    const bf16_t* Vp = Kp + 1024;
    bf16_t* Op = mixed + (size_t)(b * SEQ + qb * 256 + wid * 32) * LDO + h * 128;
    const int NT = 4 * (qb + 1);
    const int qlo = qb * 256 + wid * 32, qm = qlo + r32 - 4 * hi;
    const float slr = __builtin_amdgcn_exp2f(-(float)(h + 1)) * (1.0f / SCALE);
    bf16x8 qr[8];
#pragma unroll
    for (int d0 = 0; d0 < 8; ++d0) qr[d0] = *(const bf16x8*)(Qp + (size_t)(wid * 32 + r32) * LDQ + d0 * 16 + hi * 8);
    const int lb = wid * 1024 + lane * 16;
    const int krow = lb >> 8, kch = ((lb >> 4) & 15) ^ (krow & 7);
    const bf16_t* kg = Kp + (size_t)krow * LDQ + kch * 8;
    const int stv = lb >> 9, kkv = ((stv >> 2) << 3) | ((lb >> 6) & 7), kvv = (kkv & ~0xC) | ((kkv & 4) << 1) | ((kkv & 8) >> 1);
    const bf16_t* vg = Vp + (size_t)kvv * LDQ + (stv & 3) * 32 + ((lb >> 4) & 3) * 8;
#define FA_DMA(k0, bf) do { _Pragma("unroll") for (int i_ = 0; i_ < 2; ++i_) { \
        __builtin_amdgcn_global_load_lds((const unsigned*)(kg + (size_t)((k0) + 32 * i_) * LDQ), (FA_LAS unsigned*)(K_lds + (bf) * SHM + i_ * 8192 + wid * 1024), 16, 0, 0); \
        __builtin_amdgcn_global_load_lds((const unsigned*)(vg + (size_t)((k0) + 32 * i_) * LDQ), (FA_LAS unsigned*)(V_lds + (bf) * SHM + i_ * 8192 + wid * 1024), 16, 0, 0); } } while (0)
    FA_DMA(0, 0);
    asm volatile("s_waitcnt vmcnt(0)" ::: "memory");
    __syncthreads();
    float m_reg = -1e30f, l_reg = 0.f; f32x16 o[4];
#pragma unroll
    for (int d = 0; d < 4; ++d)
#pragma unroll
        for (int r = 0; r < 16; ++r) o[d][r] = 0.f;
    const int vb0 = (int)(uintptr_t)V_lds + v_rd_base(lane);
    const int dq15 = qm & 15, dq3 = qm & 3, r0 = (dq15 & 3) + 4 * (dq15 >> 3);
    const bool lane_valid = (dq15 & 4) == 0, r0odd = (r0 & 1) != 0;
    const bool is1 = r0 == 1, is2 = r0 == 2, is3 = r0 == 3, is4 = r0 == 4, is5 = r0 == 5, is6 = r0 == 6, is7 = r0 == 7;
    const bool rp0 = (r0 >> 1) == 0, rp1 = (r0 >> 1) == 1, rp2 = (r0 >> 1) == 2, rp3 = (r0 >> 1) == 3;
    const float fc0 = slr * (float)((r0 & 3) + 8 * (r0 >> 2));
    for (int t = 0; t < NT; ++t) {
        const int buf = t & 1, kb = t * 64;
        if (t + 1 < NT) FA_DMA(kb + 64, buf ^ 1);
        if (kb <= qlo + 31) {
            f32x16 p0, p1; const int dq = qm - kb;
            qkt<8, 256>(p0, p1, K_lds + buf * SHM, r32, hi, qr, -slr * (float)dq);
            const int dmin = qlo - kb - 63, dmax = qlo + 31 - kb;
            float alpha; bf16x8 pa0, pa1, pa2, pa3;
            if (dmin > 512) {
#define FA_SEL8(P, B_) ({ float v_ = P[B_]; v_ = is1 ? P[B_ + 1] : v_; v_ = is2 ? P[B_ + 2] : v_; v_ = is3 ? P[B_ + 3] : v_; v_ = is4 ? P[B_ + 4] : v_; v_ = is5 ? P[B_ + 5] : v_; v_ = is6 ? P[B_ + 6] : v_; v_ = is7 ? P[B_ + 7] : v_; v_; })
                const float NEG = -__builtin_inff();
                float e0 = FA_SEL8(p0, 0) + fc0, e1 = FA_SEL8(p0, 8) + (fc0 + 16.f * slr), e2 = FA_SEL8(p1, 0) + (fc0 + 32.f * slr), e3 = FA_SEL8(p1, 8) + (fc0 + 48.f * slr);
#undef FA_SEL8
                e0 = lane_valid ? e0 : NEG; e1 = lane_valid ? e1 : NEG; e2 = lane_valid ? e2 : NEG; e3 = lane_valid ? e3 : NEG;
                float pmax = fmaxf(fmaxf(e0, e1), fmaxf(e2, e3));
                { auto rr = __builtin_amdgcn_permlane32_swap(__float_as_uint(pmax), __float_as_uint(pmax), false, false); pmax = fmaxf(__uint_as_float(rr[0]), __uint_as_float(rr[1])); }
                constexpr float C2 = LOG2E * SCALE; float mn;
                if (__builtin_expect(__all((pmax - m_reg) * SCALE <= THR), 1)) { mn = m_reg; alpha = 1.f; }
                else { mn = fmaxf(m_reg, pmax); alpha = __builtin_amdgcn_exp2f((m_reg - mn) * C2); m_reg = mn; }
                const float mnL = -mn * C2;
                e0 = __builtin_amdgcn_exp2f(__builtin_fmaf(e0, C2, mnL)); e1 = __builtin_amdgcn_exp2f(__builtin_fmaf(e1, C2, mnL));
                e2 = __builtin_amdgcn_exp2f(__builtin_fmaf(e2, C2, mnL)); e3 = __builtin_amdgcn_exp2f(__builtin_fmaf(e3, C2, mnL));
                float ps = (e0 + e1) + (e2 + e3);
                { auto rr = __builtin_amdgcn_permlane32_swap(__float_as_uint(ps), __float_as_uint(ps), false, false); ps = __uint_as_float(rr[0]) + __uint_as_float(rr[1]); }
                l_reg = l_reg * alpha + ps;
#define FA_SCAT(E_, OUT) do { unsigned w_ = cvtpk(E_, 0.f); w_ = r0odd ? (w_ << 16) : w_; \
                    const unsigned a0 = rp0 ? w_ : 0u, a1 = rp1 ? w_ : 0u, b0 = rp2 ? w_ : 0u, b1 = rp3 ? w_ : 0u; \
                    auto s0 = __builtin_amdgcn_permlane32_swap(a0, b0, false, false); auto s1 = __builtin_amdgcn_permlane32_swap(a1, b1, false, false); \
                    u32x4 ww = {s0[0], s1[0], s0[1], s1[1]}; OUT = *reinterpret_cast<bf16x8*>(&ww); } while (0)
                FA_SCAT(e0, pa0); FA_SCAT(e1, pa1); FA_SCAT(e2, pa2); FA_SCAT(e3, pa3);
#undef FA_SCAT
            } else {
                if (dmin < 0) bias_tile<4>(p0, p1, dq, slr, dq15, dq3);
                else if (dmax <= 128) bias_tile<3>(p0, p1, dq, slr, dq15, dq3);
                else if (dmin <= 128) bias_tile<5>(p0, p1, dq, slr, dq15, dq3);
                else if (dmax <= 512) bias_tile<1>(p0, p1, dq, slr, dq15, dq3);
                else bias_tile<6>(p0, p1, dq, slr, dq15, dq3);
                float mn; partialSM(p0, p1, m_reg, mn, alpha);
                finishSM(p0, p1, alpha, l_reg, pa0, pa1, pa2, pa3);
            }
            if (__any(alpha < 1.f)) { if (hi == 0) al_l[r32] = alpha; asm volatile("s_waitcnt lgkmcnt(0)" ::: "memory");
#pragma unroll
                for (int d_ = 0; d_ < 4; ++d_)
#pragma unroll
                    for (int r = 0; r < 16; ++r) o[d_][r] *= al_l[crow(r, hi)]; }
            pv_tile<4096, 2048>(o, vb0 + buf * SHM, pa0, pa1, pa2, pa3);
        }
        asm volatile("s_waitcnt vmcnt(0)" ::: "memory");
        __syncthreads();
    }
#undef FA_DMA
    if (hi == 0) li_l[r32] = l_reg; asm volatile("s_waitcnt lgkmcnt(0)" ::: "memory");
#pragma unroll
    for (int r = 0; r < 16; ++r) { const int orow = crow(r, hi); const float rl = __builtin_amdgcn_rcpf(li_l[orow]);
#pragma unroll
        for (int d0 = 0; d0 < 4; ++d0) { const float v = o[d0][r] * rl; const float vn = __shfl_xor(v, 1);
            if ((r32 & 1) == 0) *(unsigned*)(Op + (size_t)orow * LDO + d0 * 32 + r32) = cvtpk(v, vn); } }
    __syncthreads();
}

__device__ __forceinline__ void ret_state_scan(const bf16_t* __restrict__ proj, bf16_t* __restrict__ state, int b, int h, int d4, int e2, char* lds) {
    int tid_ = threadIdx.x; asm volatile("" : "+v"(tid_));
    const int tid = tid_, wid = __builtin_amdgcn_readfirstlane(tid >> 6), lane = tid & 63, r32 = lane & 31, hi = lane >> 5;
    const int wd = wid & 1, we = wid >> 1;
    constexpr int STG = 24576;
    const bf16_t* Kp = proj + (size_t)(b * SEQ) * LDQ + 4096 + h * 256 + d4 * 64;
    const bf16_t* Vp = proj + (size_t)(b * SEQ) * LDQ + 5120 + h * 256 + e2 * 128;
    bf16_t* Sp = state + ((size_t)((b * 4 + h) * 16) * 256 + d4 * 64 + wd * 32) * 256 + e2 * 128 + we * 32;
    const int lb = wid * 1024 + lane * 16, stv = lb >> 9, rowin = (lb >> 6) & 7, ch = (lb >> 4) & 3;
    const int kkk = ((stv >> 1) << 3) | rowin, keyk = (kkk & ~0xC) | ((kkk & 4) << 1) | ((kkk & 8) >> 1);
    const bf16_t* kg = Kp + (size_t)keyk * LDQ + (stv & 1) * 32 + ch * 8;
    const int kkv = ((stv >> 2) << 3) | rowin, keyv = (kkv & ~0xC) | ((kkv & 4) << 1) | ((kkv & 8) >> 1);
    const bf16_t* vg = Vp + (size_t)keyv * LDQ + (stv & 3) * 32 + ch * 8;
#define FA_DMA(st_, sg_) do { char* base_ = lds + (sg_) * STG; const size_t k0_ = (size_t)(st_) * 64 * LDQ; \
        __builtin_amdgcn_global_load_lds((const unsigned*)(kg + k0_), (FA_LAS unsigned*)(base_ + wid * 1024), 16, 0, 0); \
        __builtin_amdgcn_global_load_lds((const unsigned*)(vg + k0_), (FA_LAS unsigned*)(base_ + 8192 + wid * 1024), 16, 0, 0); \
        __builtin_amdgcn_global_load_lds((const unsigned*)(vg + k0_ + (size_t)32 * LDQ), (FA_LAS unsigned*)(base_ + 16384 + wid * 1024), 16, 0, 0); } while (0)
    f32x16 R;
#pragma unroll
    for (int r = 0; r < 16; ++r) R[r] = 0.f;
    const int rb = (int)(uintptr_t)lds + v_rd_base(lane);
    FA_DMA(0, 0); FA_DMA(1, 1);
    for (int st = 0; st < 32; ++st) {
        if ((st & 1) == 0 && st > 0) {
            bf16_t* dst = Sp + (size_t)(st >> 1) * 65536;
#pragma unroll
            for (int r = 0; r < 16; ++r) { const float v = R[r]; const float vn = __shfl_xor(v, 1);
                if ((r32 & 1) == 0) *(unsigned*)(dst + (size_t)crow(r, hi) * 256 + r32) = cvtpk(v, vn); } }
        if (st + 2 < 32) { FA_DMA(st + 2, (st + 2) & 3); asm volatile("s_waitcnt vmcnt(6)" ::: "memory"); }
        else asm volatile("s_waitcnt vmcnt(0)" ::: "memory");
        __builtin_amdgcn_s_barrier(); asm volatile("" ::: "memory");
        const int ka = rb + (st & 3) * STG + wd * 512, va = rb + (st & 3) * STG + 8192 + we * 512;
#define FA_TR(dst, base, off) asm volatile("ds_read_b64_tr_b16 %0, %1 offset:%2" : "=&v"(dst) : "v"(base), "i"(off) : "memory")
        s16x4 al[4], ah[4], bl[4], bh[4];
        FA_TR(al[0], ka, 0); FA_TR(ah[0], ka, 1024); FA_TR(al[1], ka, 2048); FA_TR(ah[1], ka, 3072); FA_TR(al[2], ka, 4096); FA_TR(ah[2], ka, 5120); FA_TR(al[3], ka, 6144); FA_TR(ah[3], ka, 7168);
        FA_TR(bl[0], va, 0); FA_TR(bh[0], va, 2048); FA_TR(bl[1], va, 4096); FA_TR(bh[1], va, 6144); FA_TR(bl[2], va, 8192); FA_TR(bh[2], va, 10240); FA_TR(bl[3], va, 12288); FA_TR(bh[3], va, 14336);
        asm volatile("s_waitcnt lgkmcnt(0)" ::: "memory"); SBAR();
#pragma unroll
        for (int ks = 0; ks < 4; ++ks)
            R = __builtin_amdgcn_mfma_f32_32x32x16_bf16((bf16x8){al[ks][0], al[ks][1], al[ks][2], al[ks][3], ah[ks][0], ah[ks][1], ah[ks][2], ah[ks][3]},
                                                        (bf16x8){bl[ks][0], bl[ks][1], bl[ks][2], bl[ks][3], bh[ks][0], bh[ks][1], bh[ks][2], bh[ks][3]}, R, 0, 0, 0);
#undef FA_TR
    }
#undef FA_DMA
    __syncthreads();
}

__device__ __forceinline__ void ret_block(const bf16_t* __restrict__ proj, const bf16_t* __restrict__ state, bf16_t* __restrict__ mixed, int b, int h, int qb, char* lds) {
    int tid_ = threadIdx.x; asm volatile("" : "+v"(tid_));
    const int tid = tid_, wid = __builtin_amdgcn_readfirstlane(tid >> 6), lane = tid & 63, r32 = lane & 31, hi = lane >> 5;
    const int wq = wid & 3, e = wid >> 2;
    constexpr int SHM = 32768;
    char* V_lds = lds; char* K_lds = lds + 2 * SHM; float* ssx = (float*)(lds + 131072);
    const bf16_t* Qp = proj + (size_t)(b * SEQ + qb * 128) * LDQ + 3072 + h * 256;
    const bf16_t* Kp = proj + (size_t)(b * SEQ + qb * 128) * LDQ + 4096 + h * 256;
    const bf16_t* Vp = Kp + 1024;
    const bf16_t* Gp = Qp + 3072 + (size_t)(wq * 32) * LDQ + e * 128;
    const bf16_t* Sp = state + (size_t)((b * 4 + h) * 16 + qb) * 65536;
    bf16_t* Op = mixed + (size_t)(b * SEQ + qb * 128 + wq * 32) * LDO + 1024 + h * 256 + e * 128;
    const int qlo = wq * 32, qm = qlo + r32 - 4 * hi;
    bf16x8 qr[16];
#pragma unroll
    for (int d0 = 0; d0 < 16; ++d0) qr[d0] = *(const bf16x8*)(Qp + (size_t)(wq * 32 + r32) * LDQ + d0 * 16 + hi * 8);
    const int lb = wid * 1024 + lane * 16;
    const int krow = lb >> 9, kch = ((lb >> 4) & 31) ^ (krow & 7);
    const bf16_t* kg = Kp + (size_t)krow * LDQ + kch * 8;
    const int stv = lb >> 9, kkv = ((stv >> 3) << 3) | ((lb >> 6) & 7), kvv = (kkv & ~0xC) | ((kkv & 4) << 1) | ((kkv & 8) >> 1);
    const bf16_t* vg = Vp + (size_t)kvv * LDQ + (stv & 7) * 32 + ((lb >> 4) & 3) * 8;
    const bf16_t* sg = Sp + (size_t)kvv * 256 + (stv & 7) * 32 + ((lb >> 4) & 3) * 8;
#define FA_DMA(k0, bf) do { _Pragma("unroll") for (int i_ = 0; i_ < 4; ++i_) { \
        __builtin_amdgcn_global_load_lds((const unsigned*)(kg + (size_t)((k0) + 16 * i_) * LDQ), (FA_LAS unsigned*)(K_lds + (bf) * SHM + i_ * 8192 + wid * 1024), 16, 0, 0); \
        __builtin_amdgcn_global_load_lds((const unsigned*)(vg + (size_t)((k0) + 16 * i_) * LDQ), (FA_LAS unsigned*)(V_lds + (bf) * SHM + i_ * 8192 + wid * 1024), 16, 0, 0); } } while (0)
#define FA_DMAS(j_, bf) do { _Pragma("unroll") for (int i_ = 0; i_ < 4; ++i_) \
        __builtin_amdgcn_global_load_lds((const unsigned*)(sg + (size_t)(64 * (j_) + 16 * i_) * 256), (FA_LAS unsigned*)(V_lds + (bf) * SHM + i_ * 8192 + wid * 1024), 16, 0, 0); } while (0)
#define FA_BAR() do { __builtin_amdgcn_s_barrier(); asm volatile("" ::: "memory"); } while (0)
#define FA_DMASX(j_, dstp) do { _Pragma("unroll") for (int i_ = 0; i_ < 4; ++i_) \
        __builtin_amdgcn_global_load_lds((const unsigned*)(sg + (size_t)(64 * (j_) + 16 * i_) * 256), (FA_LAS unsigned*)((dstp) + i_ * 8192 + wid * 1024), 16, 0, 0); } while (0)
    FA_DMA(0, 0); FA_DMA(64, 1);
    f32x16 o[4];
#pragma unroll
    for (int d = 0; d < 4; ++d)
#pragma unroll
        for (int r = 0; r < 16; ++r) o[d][r] = 0.f;
    const int vrd = v_rd_base(lane) + e * 2048;
    const int vbV = (int)(uintptr_t)V_lds + vrd, vbK = (int)(uintptr_t)K_lds + vrd;
    const bool has_state = qb > 0;
    asm volatile("s_waitcnt vmcnt(8)" ::: "memory"); FA_BAR();
#pragma unroll
    for (int t = 0; t < 2; ++t) {
        const int buf = t, kb = t * 64;
        if (kb <= qlo + 31) {
            const bool diag = kb + 63 > qlo; const int dq = qm - kb;
            bf16x8 pa0, pa1, pa2, pa3;
            { f32x16 p; qkt1<16, 512>(p, K_lds + buf * SHM, r32, hi, qr);
              if (diag) {
#pragma unroll
                  for (int r = 0; r < 16; ++r) { const int C = (r & 3) + 8 * (r >> 2); if (dq - C < 0) p[r] = 0.f; } }
              FA_PK4(p, 0, pa0); FA_PK4(p, 8, pa1); }
            { f32x16 p; qkt1<16, 512>(p, K_lds + buf * SHM + 32 * 512, r32, hi, qr);
              if (diag) {
#pragma unroll
                  for (int r = 0; r < 16; ++r) { const int C = (r & 3) + 8 * (r >> 2) + 32; if (dq - C < 0) p[r] = 0.f; } }
              FA_PK4(p, 0, pa2); FA_PK4(p, 8, pa3); }
            pv_tile<8192, 4096>(o, vbV + buf * SHM, pa0, pa1, pa2, pa3);
        }
        if (t == 0) {
            asm volatile("s_waitcnt lgkmcnt(0)" ::: "memory"); FA_BAR();
            if (has_state) { FA_DMASX(0, V_lds); FA_DMASX(1, K_lds); asm volatile("s_waitcnt vmcnt(8)" ::: "memory"); }
            else asm volatile("s_waitcnt vmcnt(0)" ::: "memory");
            FA_BAR();
        }
    }
    if (has_state) {
        asm volatile("s_waitcnt lgkmcnt(0)" ::: "memory"); FA_BAR();
        FA_DMASX(2, V_lds + SHM); FA_DMASX(3, K_lds + SHM);
        asm volatile("s_waitcnt vmcnt(12)" ::: "memory"); FA_BAR();
        pv_tile<8192, 4096>(o, vbV, qr[0], qr[1], qr[2], qr[3]);
        asm volatile("s_waitcnt vmcnt(8)" ::: "memory"); FA_BAR();
        pv_tile<8192, 4096>(o, vbK, qr[4], qr[5], qr[6], qr[7]);
        asm volatile("s_waitcnt vmcnt(4)" ::: "memory"); FA_BAR();
        pv_tile<8192, 4096>(o, vbV + SHM, qr[8], qr[9], qr[10], qr[11]);
        asm volatile("s_waitcnt vmcnt(0)" ::: "memory"); FA_BAR();
        pv_tile<8192, 4096>(o, vbK + SHM, qr[12], qr[13], qr[14], qr[15]);
    }
#undef FA_BAR
#undef FA_DMASX
#undef FA_DMA
#undef FA_DMAS
    bf16_t graw[16][4];
#pragma unroll
    for (int r = 0; r < 16; ++r)
#pragma unroll
        for (int d0 = 0; d0 < 4; ++d0) graw[r][d0] = Gp[(size_t)crow(r, hi) * LDQ + d0 * 32 + r32];
    float ssr[16];
#pragma unroll
    for (int r = 0; r < 16; ++r) { float s = 0.f;
#pragma unroll
        for (int d0 = 0; d0 < 4; ++d0) s += o[d0][r] * o[d0][r];
        s += __shfl_xor(s, 1); s += __shfl_xor(s, 2); s += __shfl_xor(s, 4); s += __shfl_xor(s, 8); s += __shfl_xor(s, 16);
        ssr[r] = s; }
    if (r32 == 0) {
#pragma unroll
        for (int r = 0; r < 16; ++r) ssx[e * 128 + wq * 32 + crow(r, hi)] = ssr[r]; }
    __syncthreads();
#pragma unroll
    for (int r = 0; r < 16; ++r) { const int orow = crow(r, hi); const float tot = ssx[wq * 32 + orow] + ssx[128 + wq * 32 + orow];
        const float rs = __builtin_amdgcn_rsqf(tot * (1.0f / 256.0f) + 1e-6f);
#pragma unroll
        for (int d0 = 0; d0 < 4; ++d0) { const float g = bf2f(graw[r][d0]);
            const float v = o[d0][r] * rs * g * __builtin_amdgcn_rcpf(1.0f + __builtin_amdgcn_exp2f(-LOG2E * g)); const float vn = __shfl_xor(v, 1);
            if ((r32 & 1) == 0) *(unsigned*)(Op + (size_t)orow * LDO + d0 * 32 + r32) = cvtpk(v, vn); } }
    __syncthreads();
}
#undef SBAR
}

#ifndef MK_N_LAUNCHES
#define MK_N_LAUNCHES 1
#endif
constexpr int NWAVES = 8, NPHASE = 8;
constexpr int BATCH = 8, SEQ = 2048, DM = 2048, M = BATCH * SEQ, NPROJ = 7168, FF = 5632, NGU = 2 * FF;
constexpr float NORM_EPS = 1e-6f;
constexpr size_t MiB = 1u << 20;
constexpr size_t WS_SS = 0, WS_BAR = 131072, CTL_ZERO_BYTES = 196608;
constexpr size_t WS_WIN = 1 * MiB, WS_WOUT = 29 * MiB, WS_WGU = 37 * MiB, WS_WDN = 81 * MiB;
constexpr size_t WS_H = 104 * MiB;
constexpr size_t WS_PROJ = 168 * MiB;
constexpr size_t WS_MIXED = 392 * MiB, WS_END = 456 * MiB;
constexpr int RING_BYTES = 131072, LDS_BYTES = 135168;

typedef unsigned short bf16;
typedef unsigned v4u __attribute__((ext_vector_type(4)));
typedef unsigned v2u __attribute__((ext_vector_type(2)));
typedef float f32x4 __attribute__((ext_vector_type(4)));
#define LAS __attribute__((address_space(3)))
__device__ __forceinline__ unsigned f2bf(float f) { unsigned u = __builtin_bit_cast(unsigned, f); return (u + 0x7fffu + ((u >> 16) & 1u)) >> 16; }
__device__ __forceinline__ unsigned pk2(float lo, float hi) { return f2bf(lo) | (f2bf(hi) << 16); }
__device__ __forceinline__ float wave_sum(float v) {
#pragma unroll
    for (int o = 1; o < 64; o <<= 1) v += __shfl_xor(v, o);
    return v;
}
#define XB_TMO      128
#define XB_XCNT(j)  (256  + 64 * (j))
#define XB_XSUB(j)  (1280 + 64 * (j))
#define XB_XGEN(j)  (2304 + 64 * (j))
#define XB_TOP      3328
#define XB_TOPGEN   3392
#define XCD_BAR_WORDS 3456
#define XB_SPIN_CAP (1u << 18)

__device__ __forceinline__ unsigned xb_ld(unsigned* p)              { return __hip_atomic_load(p, __ATOMIC_RELAXED, __HIP_MEMORY_SCOPE_AGENT); }
__device__ __forceinline__ unsigned xb_add(unsigned* p, unsigned v) { return __hip_atomic_fetch_add(p, v, __ATOMIC_RELAXED, __HIP_MEMORY_SCOPE_AGENT); }
__device__ __forceinline__ unsigned xb_xcc_id() { return (unsigned)__builtin_amdgcn_s_getreg((3 << 11) | 20) & 0xFu; }
#define XB_SPIN(cond, bar) do { unsigned _sp = 0; while (cond) { __builtin_amdgcn_s_sleep(1); \
    if ((++_sp & 255u) == 0u) { if (xb_ld(&(bar)[XB_TMO])) break; if (_sp > XB_SPIN_CAP) { atomicAdd(&(bar)[XB_TMO], 1u); break; } } } } while (0)

struct XcdBarrier {
    unsigned* bar; unsigned x;
    volatile LAS unsigned* st;
};

__device__ __forceinline__ XcdBarrier xcd_barrier_post(unsigned* bar, volatile LAS unsigned* st) {
    XcdBarrier b; b.bar = bar; b.x = xb_xcc_id(); b.st = st;
    if (threadIdx.x == 0) (void)xb_add(&bar[XB_XCNT(b.x)], 1u);
    return b;
}
__device__ __forceinline__ void xcd_barrier_complete(unsigned* bar, unsigned x, unsigned& nloc, unsigned& nx) {
    const unsigned G = gridDim.x * gridDim.y * gridDim.z;
    unsigned sum, cnt, mine, sp = 0u;
    for (;;) {
        sum = 0u; cnt = 0u; mine = 0u;
#pragma unroll
        for (unsigned j = 0; j < 16; ++j) { const unsigned c = xb_ld(&bar[XB_XCNT(j)]); sum += c; cnt += (c > 0u) ? 1u : 0u; mine = (j == x) ? c : mine; }
        if (sum == G) break;
        __builtin_amdgcn_s_sleep(1);
        if ((++sp & 255u) == 0u) { if (xb_ld(&bar[XB_TMO])) break; if (sp > XB_SPIN_CAP) { atomicAdd(&bar[XB_TMO], 1u); break; } }
    }
    nloc = mine > 0u ? mine : 1u; nx = cnt > 0u ? cnt : 1u;
}

__device__ __forceinline__ void xcd_barrier(const XcdBarrier& b) {
    asm volatile("s_waitcnt vmcnt(0)" ::: "memory");
    __syncthreads();
    if (threadIdx.x == 0) {
        unsigned* bar = b.bar;
        __builtin_amdgcn_s_waitcnt(0);
        unsigned nloc = b.st[0], nx = b.st[1];
        if (nloc == 0u) { xcd_barrier_complete(bar, b.x, nloc, nx); b.st[0] = nloc; b.st[1] = nx; }
        const unsigned old = xb_add(&bar[XB_XSUB(b.x)], 1u);
        const unsigned gen = old / nloc;
        if (old + 1u == (gen + 1u) * nloc) {
            __builtin_amdgcn_fence(__ATOMIC_RELEASE, "agent");
            asm volatile("s_waitcnt vmcnt(0)" ::: "memory");
            const unsigned og = xb_add(&bar[XB_TOP], 1u);
            const unsigned tg = og / nx;
            if (og + 1u == (tg + 1u) * nx) xb_add(&bar[XB_TOPGEN], 1u);
            else XB_SPIN(xb_ld(&bar[XB_TOPGEN]) == tg, bar);
            __builtin_amdgcn_fence(__ATOMIC_ACQUIRE, "agent");
            xb_add(&bar[XB_XGEN(b.x)], 1u);
            asm volatile("s_waitcnt vmcnt(0)" ::: "memory");
        } else {
            XB_SPIN(xb_ld(&bar[XB_XGEN(b.x)]) == gen, bar);
            __builtin_amdgcn_fence(__ATOMIC_ACQUIRE, "agent");
            asm volatile("s_waitcnt vmcnt(0)" ::: "memory");
        }
    }
    __syncthreads();
}

__device__ __forceinline__ unsigned cvtpk2(float lo, float hi) { unsigned r; asm volatile("v_cvt_pk_bf16_f32 %0, %1, %2" : "=v"(r) : "v"(lo), "v"(hi)); return r; }
__device__ __forceinline__ void p0_transpose_item(const float* __restrict__ W, int K, int N, bf16* __restrict__ WT, int mode, const float* __restrict__ kscale, int item, int lane) {
    const int nblk = N / 64, kb = item / nblk, nb = item % nblk, k0 = 64 * kb, n0 = 64 * nb;
    const float* src = W + (size_t)k0 * N + n0 + lane;
    float v[64];
#pragma unroll
    for (int i = 0; i < 64; ++i) v[i] = src[(size_t)i * N];
    if (kscale) {
#pragma unroll
        for (int i = 0; i < 64; ++i) v[i] *= kscale[k0 + i]; }
    const int rbase = (mode == 0) ? n0 : (256 * (n0 >> 7) + (n0 & 127) + (mode == 2 ? 128 : 0));
    bf16* dst = WT + (size_t)(rbase + lane) * K + k0;
#pragma unroll
    for (int j = 0; j < 8; ++j) { v4u o; o.x = cvtpk2(v[8 * j], v[8 * j + 1]); o.y = cvtpk2(v[8 * j + 2], v[8 * j + 3]); o.z = cvtpk2(v[8 * j + 4], v[8 * j + 5]); o.w = cvtpk2(v[8 * j + 6], v[8 * j + 7]);
        *(v4u*)(dst + 8 * j) = o; }
}

struct ConvOrder : pg8::StaticOrder {
    const float *w_out, *w_gate, *w_up, *w_down, *kscale; bf16 *Wout_t, *Wgu_t, *Wdn_t; int gw, ngw; mutable int nxt;
    static constexpr int I_OUT = (DM / 64) * (DM / 64), I_G = (DM / 64) * (FF / 64), I_DN = (FF / 64) * (DM / 64), NITEMS = I_OUT + 2 * I_G + I_DN;
    __device__ __forceinline__ void convert(int r, int lane) const {
        if (r < I_OUT) { p0_transpose_item(w_out, DM, DM, Wout_t, 0, nullptr, r, lane); return; } r -= I_OUT;
        if (r < I_G) { p0_transpose_item(w_gate, DM, FF, Wgu_t, 1, kscale, r, lane); return; } r -= I_G;
        if (r < I_G) { p0_transpose_item(w_up, DM, FF, Wgu_t, 2, kscale, r, lane); return; } r -= I_G;
        p0_transpose_item(w_down, FF, DM, Wdn_t, 0, nullptr, r, lane);
    }
    __device__ __forceinline__ void done(const pg8::Unit&) const {
        if (nxt < NITEMS) { convert(nxt, (int)(threadIdx.x & 63)); nxt += ngw; asm volatile("s_waitcnt vmcnt(0)" ::: "memory"); }
    }
    __device__ __forceinline__ void finish() const { while (nxt < NITEMS) { convert(nxt, (int)(threadIdx.x & 63)); nxt += ngw; } }
};

struct Args { const float* in[9]; float* out; unsigned char* ws; int ph_lo, ph_hi; };
__global__ void __launch_bounds__(NWAVES * 64, 2) hybrid_fwd(Args args) {
    extern __shared__ __attribute__((aligned(16))) unsigned char lds[];
    cg::grid_group grid = cg::this_grid();
    const int tid = threadIdx.x, lane = tid & 63, wave = __builtin_amdgcn_readfirstlane(tid >> 6);
    const int G = gridDim.x, bx = blockIdx.x, vcu = (G % 8 == 0) ? (bx % 8) * (G / 8) + bx / 8 : bx;
    const float* x = args.in[0]; const float* norm_mix_w = args.in[1]; const float* w_in = args.in[2]; const float* w_out = args.in[3]; const float* norm_ffn_w = args.in[4];
    const float* w_gate = args.in[5]; const float* w_up = args.in[6]; const float* w_down = args.in[7]; const float* norm_final_w = args.in[8];
    float* out = args.out; unsigned char* ws = args.ws;
    float* SS1 = (float*)(ws + WS_SS); float* SS2 = SS1 + M;
    bf16* Win_t = (bf16*)(ws + WS_WIN); bf16* Wout_t = (bf16*)(ws + WS_WOUT); bf16* Wgu_t = (bf16*)(ws + WS_WGU); bf16* Wdn_t = (bf16*)(ws + WS_WDN);
    bf16* HB = (bf16*)(ws + WS_H); bf16* PROJ = (bf16*)(ws + WS_PROJ); bf16* ACT = (bf16*)(ws + WS_PROJ); bf16* MIXED = (bf16*)(ws + WS_MIXED);
    const int lo = args.ph_lo, hi = args.ph_hi;
#define IN(k) (lo <= (k) && (k) < hi)
    volatile LAS unsigned* MISC = (volatile LAS unsigned*)((LAS unsigned char*)lds + LDS_BYTES - 64);
    if (tid < 16) MISC[tid] = 0u;
    __syncthreads();
    XcdBarrier bar = xcd_barrier_post((unsigned*)(ws + WS_BAR), MISC);
    if (hi > 1000) grid.sync();
#define GRID_BAR(k) do { if (IN(k) && IN((k) + 1)) xcd_barrier(bar); } while (0)
    const int gw = vcu * NWAVES + wave, NGW = G * NWAVES;

    if (IN(0)) {
        constexpr int I_IN = (DM / 64) * (NPROJ / 64);
        for (int it = gw; it < I_IN; it += NGW) p0_transpose_item(w_in, DM, NPROJ, Win_t, 0, nullptr, it, lane);
        f32x4 wmix[8];
#pragma unroll
        for (int j = 0; j < 8; ++j) wmix[j] = ((const f32x4*)norm_mix_w + lane)[64 * j];
        for (int m0 = gw * 4; m0 < M; m0 += NGW * 4) {
            f32x4 v[4][8]; float s[4] = {0.f, 0.f, 0.f, 0.f};
#pragma unroll
            for (int q = 0; q < 4; ++q) { const f32x4* xr = (const f32x4*)(x + (size_t)(m0 + q) * DM) + lane;
#pragma unroll
                for (int j = 0; j < 8; ++j) v[q][j] = xr[64 * j]; }
#pragma unroll
            for (int q = 0; q < 4; ++q)
#pragma unroll
                for (int j = 0; j < 8; ++j) s[q] += (v[q][j].x * v[q][j].x + v[q][j].y * v[q][j].y) + (v[q][j].z * v[q][j].z + v[q][j].w * v[q][j].w);
#pragma unroll
            for (int q = 0; q < 4; ++q) { const float rs = __builtin_amdgcn_rsqf(wave_sum(s[q]) * (1.f / DM) + NORM_EPS);
                v2u* o8 = (v2u*)(HB + (size_t)(m0 + q) * DM) + lane;
#pragma unroll
                for (int j = 0; j < 8; ++j) { const f32x4 w = wmix[j]; v2u o; o.x = cvtpk2(v[q][j].x * rs * w.x, v[q][j].y * rs * w.y); o.y = cvtpk2(v[q][j].z * rs * w.z, v[q][j].w * rs * w.w); o8[64 * j] = o; } }
        }
    }
    GRID_BAR(0);

    if (IN(1)) {
        pg8::Gemm g{HB, Win_t, M, NPROJ, DM}; ConvOrder S; S.init(M, NPROJ, G, bx, 8);
        S.w_out = w_out; S.w_gate = w_gate; S.w_up = w_up; S.w_down = w_down; S.kscale = norm_ffn_w; S.Wout_t = Wout_t; S.Wgu_t = Wgu_t; S.Wdn_t = Wdn_t; S.gw = gw; S.ngw = NGW; S.nxt = gw;
        pg8::EpiProj E{PROJ, NPROJ};
        pg8::gemm_phase<pg8::EpiProj, ConvOrder, true, true>((LAS unsigned char*)lds, g, S, E);
        S.finish();
    }
    GRID_BAR(1);

    if (IN(2)) {
        for (int it = vcu; it < 256; it += G) fa::ret_state_scan(PROJ, HB, it >> 5, (it >> 3) & 3, (it >> 1) & 3, it & 1, (char*)lds);
    }
    GRID_BAR(2);

    if (IN(3)) {
        for (int it = vcu; it < 256; it += G) { const int bh = it >> 2, s = it & 3;
#pragma unroll 1
            for (int ps = 0; ps < 2; ++ps) fa::attn_block(PROJ, MIXED, bh >> 3, bh & 7, ps ? s : 7 - s, (char*)lds); }
        for (int it = vcu; it < 256; it += G) { const int bh = it >> 3, s = it & 7;
#pragma unroll 1
            for (int ps = 0; ps < 2; ++ps) fa::ret_block(PROJ, HB, MIXED, bh >> 2, bh & 3, ps ? s : 15 - s, (char*)lds); }
    }
    GRID_BAR(3);

    if (IN(4)) {
        pg8::Gemm g{MIXED, Wout_t, M, DM, DM}; pg8::StaticOrder S; S.init(M, DM, G, bx);
        pg8::EpiRes<false> E{x, HB, SS1, DM};
        pg8::gemm_phase<pg8::EpiRes<false>, pg8::StaticOrder, true, true>((LAS unsigned char*)lds, g, S, E);
    }
    GRID_BAR(4);

    if (IN(5)) {
        pg8::Gemm g{HB, Wgu_t, M, NGU, DM}; pg8::StaticOrder S; S.init(M, NGU, G, bx, 8);
        pg8::EpiGU E{ACT, FF, SS1, 1.f / DM, NORM_EPS};
        pg8::gemm_phase<pg8::EpiGU, pg8::StaticOrder, true, true>((LAS unsigned char*)lds, g, S, E);
    }
    GRID_BAR(5);

    if (IN(6)) {
        pg8::Gemm g{ACT, Wdn_t, M, DM, FF}; pg8::StaticOrder S; S.init(M, DM, G, bx);
        pg8::EpiRes<true> E{HB, MIXED, SS2, DM};
        pg8::gemm_phase<pg8::EpiRes<true>, pg8::StaticOrder, true, true>((LAS unsigned char*)lds, g, S, E);
    }
    GRID_BAR(6);

    if (IN(7)) {
        f32x4 wfin[8];
#pragma unroll
        for (int j = 0; j < 8; ++j) wfin[j] = ((const f32x4*)norm_final_w + lane)[64 * j];
        for (int m0 = gw * 4; m0 < M; m0 += NGW * 4) {
            v2u r[4][8]; float rs[4];
#pragma unroll
            for (int q = 0; q < 4; ++q) { const v2u* xr = (const v2u*)(MIXED + (size_t)(m0 + q) * DM) + lane; rs[q] = __builtin_amdgcn_rsqf(SS2[m0 + q] * (1.f / DM) + NORM_EPS);
#pragma unroll
                for (int j = 0; j < 8; ++j) r[q][j] = xr[64 * j]; }
#pragma unroll
            for (int q = 0; q < 4; ++q) { f32x4* orow = (f32x4*)(out + (size_t)(m0 + q) * DM) + lane;
#pragma unroll
                for (int j = 0; j < 8; ++j) { const f32x4 w = wfin[j]; const float s = rs[q];
                    orow[64 * j] = (f32x4){__uint_as_float(r[q][j].x << 16) * s * w.x, __uint_as_float(r[q][j].x & 0xffff0000u) * s * w.y, __uint_as_float(r[q][j].y << 16) * s * w.z, __uint_as_float(r[q][j].y & 0xffff0000u) * s * w.w}; } }
        }
    }
#undef IN
#undef GRID_BAR
}

extern "C" void kernel_launch(void* const* d_in, const int* in_sizes, int n_in, void* d_out, int out_size, void* d_ws, size_t ws_size, hipStream_t stream) {
    static int grid = 0;
    if (grid == 0) {
        if (n_in != 9 || in_sizes[0] != M * DM || out_size != M * DM || ws_size < WS_END) { fprintf(stderr, "kernel_launch: unexpected shapes (n_in %d, in0 %d, out %d, ws %zu)\n", n_in, n_in > 0 ? in_sizes[0] : -1, out_size, ws_size); grid = -1; return; }
        int dev = 0, cus = 0, per_cu = 0;
        (void)hipGetDevice(&dev); (void)hipDeviceGetAttribute(&cus, hipDeviceAttributeMultiprocessorCount, dev);
        if (hipFuncSetAttribute((const void*)hybrid_fwd, hipFuncAttributeMaxDynamicSharedMemorySize, LDS_BYTES) != hipSuccess) { fprintf(stderr, "kernel_launch: hipFuncSetAttribute failed\n"); grid = -1; return; }
        if (hipOccupancyMaxActiveBlocksPerMultiprocessor(&per_cu, (const void*)hybrid_fwd, NWAVES * 64, LDS_BYTES) != hipSuccess || per_cu < 1) { fprintf(stderr, "kernel_launch: occupancy query says %d\n", per_cu); per_cu = 1; }
        (void)hipGetLastError();
        grid = cus * per_cu;
    }
    if (grid < 0) return;
    if (hipMemsetAsync((char*)d_ws + WS_SS, 0, CTL_ZERO_BYTES, stream) != hipSuccess) { fprintf(stderr, "kernel_launch: hipMemsetAsync failed\n"); return; }
    Args a{};
    for (int i = 0; i < 9; ++i) a.in[i] = (const float*)d_in[i];
    a.out = (float*)d_out; a.ws = (unsigned char*)d_ws;
#if MK_N_LAUNCHES == 1
    a.ph_lo = 0; a.ph_hi = NPHASE;
    void* kargs[] = {&a};
    const hipError_t le = hipLaunchCooperativeKernel((const void*)hybrid_fwd, dim3(grid), dim3(NWAVES * 64), kargs, LDS_BYTES, stream);
    if (le != hipSuccess) fprintf(stderr, "kernel_launch: cooperative launch failed: %s (grid %d)\n", hipGetErrorString(le), grid);
#else
    for (int p = 0; p < NPHASE; ++p) { a.ph_lo = p; a.ph_hi = p + 1; hipLaunchKernelGGL(hybrid_fwd, dim3(grid), dim3(NWAVES * 64), LDS_BYTES, stream, a); }
#endif
}
```

```cpp
#include <hip/hip_runtime.h>
#include <hip/hip_cooperative_groups.h>
#include <cstdio>
#include <cstdint>
namespace cg = cooperative_groups;
namespace pg8 {
#define PG8_LAS __attribute__((address_space(3)))
typedef unsigned short bf16_t;
typedef short bf16x8 __attribute__((ext_vector_type(8)));
typedef float f32x4 __attribute__((ext_vector_type(4)));
typedef unsigned u32x4 __attribute__((ext_vector_type(4)));
constexpr int BM = 256, BK = 64, HALF = 128, HTB = HALF * BK * 2  , STAGE_BYTES = 8 * HTB, NXCD = 8, WGM = 4;

__host__ __device__ __forceinline__ int lds_byte(int r, int c) { const int st = (r >> 4) * 2 + (c >> 5), rr = r & 15, cc = c & 31, ob = rr * 64 + cc * 2; return st * 1024 + (ob ^ (((ob >> 9) & 1) << 5)); }
__host__ __device__ __forceinline__ void stage_rc(int b, int& R, int& C) { const int st = b / 1024, sb = b % 1024, swz = sb ^ (((sb >> 9) & 1) << 5); R = (st >> 1) * 16 + swz / 64; C = (st & 1) * 32 + (swz % 64) / 2; }
__host__ __device__ __forceinline__ int perm32(int rho) { const int n = rho >> 4, i = rho & 15; return 8 * (i >> 2) + 4 * n + (i & 3); }

struct Unit { int pm, pn; };
struct Gemm { const bf16_t* A; const bf16_t* Bt; int M, N, K; };

struct StaticOrder {
    int nM, nN, nwg, G, c, wgm;
    __host__ __device__ void init(int M, int N, int G_, int c_, int wgm_ = WGM) { nM = M / BM; nN = N / BM; nwg = nM * nN; G = G_; c = c_; wgm = wgm_; }
    __host__ __device__ bool next(int i, Unit& u) const {
        const long L = (long)i * G + c; if (L >= nwg) return false;
        int wgid = (int)L; { const int q = nwg / NXCD, r = nwg % NXCD, xcd = wgid % NXCD, off = wgid / NXCD; wgid = (xcd < r ? xcd * (q + 1) : r * (q + 1) + (xcd - r) * q) + off; }
        const int nig = wgm * nN, gid = wgid / nig, fm = gid * wgm, gsz = (nM - fm) < wgm ? (nM - fm) : wgm;
        u.pm = fm + ((wgid % nig) % gsz); u.pn = (wgid % nig) / gsz; return true;
    }
    __device__ __forceinline__ void a_ready(const Unit&) const {}
    __device__ __forceinline__ void done(const Unit&) const {}
};

__device__ __forceinline__ unsigned cvt_pk_bf16(float lo, float hi) { unsigned r; asm volatile("v_cvt_pk_bf16_f32 %0, %1, %2" : "=v"(r) : "v"(lo), "v"(hi)); return r; }
typedef unsigned u32x2 __attribute__((ext_vector_type(2)));

struct EpiProj {
    static constexpr bool PERM = true, AFTER_DRAIN = false;
    bf16_t* O; int ldc;
    __device__ __forceinline__ void operator()(const f32x4 (&acc)[2][2][4][2], const Unit& u, int wr, int wc, int fr, int fq) const {
        const int row0 = u.pm * BM + wr * 64 + fr, col0 = u.pn * BM + wc * 32 + 8 * fq;
        const int mode = (u.pn >= 12 && u.pn < 16) ? 1 : ((u.pn >= 16 && u.pn < 20) ? 2 : 0);
        float lg = 0.f; if (mode) { const int hd = (u.pn - 12) & 3; lg = __log2f(1.0f - __builtin_amdgcn_exp2f(-5.0f - (float)hd)); }
#pragma unroll
        for (int ai = 0; ai < 2; ++ai)
#pragma unroll
            for (int m = 0; m < 4; ++m) { const int row = row0 + ai * HALF + m * 16; bf16_t* rowp = O + (size_t)row * ldc + col0;
                float sc = 1.f;
                if (mode) { const float e = (float)((row & 2047) - 1024) * lg; sc = (mode == 1) ? __builtin_amdgcn_exp2f(e) : __builtin_amdgcn_exp2f(-e) * 0.0625f; }
#pragma unroll
                for (int bj = 0; bj < 2; ++bj) { const f32x4 v0 = acc[ai][bj][m][0] * sc, v1 = acc[ai][bj][m][1] * sc;
                    u32x4 w; w.x = cvt_pk_bf16(v0[0], v0[1]); w.y = cvt_pk_bf16(v0[2], v0[3]); w.z = cvt_pk_bf16(v1[0], v1[1]); w.w = cvt_pk_bf16(v1[2], v1[3]);
                    *(u32x4*)(rowp + bj * HALF) = w; } }
    }
};
template <bool BASE_BF16> struct EpiRes {
    static constexpr bool PERM = true, AFTER_DRAIN = false;
    const void* base; bf16_t* out; float* ss; int ldc;
    __device__ __forceinline__ void tail(const f32x4& b0, const f32x4& b1, const f32x4& a0, const f32x4& a1, bf16_t* dst, float& s) const {
        const f32x4 o0 = b0 + a0, o1 = b1 + a1;
        s += ((o0[0] * o0[0] + o0[1] * o0[1]) + (o0[2] * o0[2] + o0[3] * o0[3])) + ((o1[0] * o1[0] + o1[1] * o1[1]) + (o1[2] * o1[2] + o1[3] * o1[3]));
        u32x4 w; w.x = cvt_pk_bf16(o0[0], o0[1]); w.y = cvt_pk_bf16(o0[2], o0[3]); w.z = cvt_pk_bf16(o1[0], o1[1]); w.w = cvt_pk_bf16(o1[2], o1[3]);
        *(u32x4*)dst = w;
    }
    __device__ __forceinline__ void operator()(const f32x4 (&acc)[2][2][4][2], const Unit& u, int wr, int wc, int fr, int fq) const {
        const int col0 = u.pn * BM + wc * 32 + 8 * fq;
        if constexpr (BASE_BF16) {
            u32x4 raw[2][4][2];
#pragma unroll
            for (int ai = 0; ai < 2; ++ai)
#pragma unroll
                for (int m = 0; m < 4; ++m) { const int row = u.pm * BM + ai * HALF + wr * 64 + m * 16 + fr; const size_t off = (size_t)row * ldc + col0;
#pragma unroll
                    for (int bj = 0; bj < 2; ++bj) raw[ai][m][bj] = *(const u32x4*)((const bf16_t*)base + off + bj * HALF); }
            asm volatile("" ::: "memory");
#pragma unroll
            for (int ai = 0; ai < 2; ++ai)
#pragma unroll
                for (int m = 0; m < 4; ++m) { const int row = u.pm * BM + ai * HALF + wr * 64 + m * 16 + fr; const size_t off = (size_t)row * ldc + col0; float s = 0.f;
#pragma unroll
                    for (int bj = 0; bj < 2; ++bj) { const u32x4 r = raw[ai][m][bj];
                        const f32x4 b0 = {__uint_as_float(r.x << 16), __uint_as_float(r.x & 0xffff0000u), __uint_as_float(r.y << 16), __uint_as_float(r.y & 0xffff0000u)};
                        const f32x4 b1 = {__uint_as_float(r.z << 16), __uint_as_float(r.z & 0xffff0000u), __uint_as_float(r.w << 16), __uint_as_float(r.w & 0xffff0000u)};
                        tail(b0, b1, acc[ai][bj][m][0], acc[ai][bj][m][1], out + off + bj * HALF, s); }
                    s += __shfl_xor(s, 16); s += __shfl_xor(s, 32);
                    if (fq == 0) atomicAdd(ss + row, s); }
        } else {
            f32x4 qa0[2][2], qa1[2][2], qb0[2][2], qb1[2][2];
#define EPI_LDQ(Q0, Q1, qi) do { _Pragma("unroll") for (int mm = 0; mm < 2; ++mm) { const int row_ = u.pm * BM + ((qi) >> 1) * HALF + wr * 64 + (((qi) & 1) * 2 + mm) * 16 + fr; \
                const float* bp_ = (const float*)base + (size_t)row_ * ldc + col0; \
                _Pragma("unroll") for (int bj = 0; bj < 2; ++bj) { Q0[mm][bj] = *(const f32x4*)(bp_ + bj * HALF); Q1[mm][bj] = *(const f32x4*)(bp_ + bj * HALF + 4); } } } while (0)
#define EPI_DOQ(Q0, Q1, qi) do { _Pragma("unroll") for (int mm = 0; mm < 2; ++mm) { const int ai_ = (qi) >> 1, m_ = ((qi) & 1) * 2 + mm; const int row_ = u.pm * BM + ai_ * HALF + wr * 64 + m_ * 16 + fr; \
                const size_t off_ = (size_t)row_ * ldc + col0; float s = 0.f; \
                _Pragma("unroll") for (int bj = 0; bj < 2; ++bj) tail(Q0[mm][bj], Q1[mm][bj], acc[ai_][bj][m_][0], acc[ai_][bj][m_][1], out + off_ + bj * HALF, s); \
                s += __shfl_xor(s, 16); s += __shfl_xor(s, 32); if (fq == 0) atomicAdd(ss + row_, s); } } while (0)
            EPI_LDQ(qa0, qa1, 0); EPI_LDQ(qb0, qb1, 1); asm volatile("" ::: "memory");
            EPI_DOQ(qa0, qa1, 0); EPI_LDQ(qa0, qa1, 2); asm volatile("" ::: "memory");
            EPI_DOQ(qb0, qb1, 1); EPI_LDQ(qb0, qb1, 3); asm volatile("" ::: "memory");
            EPI_DOQ(qa0, qa1, 2); asm volatile("" ::: "memory");
            EPI_DOQ(qb0, qb1, 3);
#undef EPI_LDQ
#undef EPI_DOQ
        }
    }
};
struct EpiGU {
    static constexpr bool PERM = true, AFTER_DRAIN = false;
    bf16_t* O; int ldc; const float* ss; float inv_n, eps;
    __device__ __forceinline__ void operator()(const f32x4 (&acc)[2][2][4][2], const Unit& u, int wr, int wc, int fr, int fq) const {
        const int row0 = u.pm * BM + wr * 64 + fr, col0 = u.pn * HALF + wc * 32 + 8 * fq;
        float rsv[2][4];
#pragma unroll
        for (int ai = 0; ai < 2; ++ai)
#pragma unroll
            for (int m = 0; m < 4; ++m) rsv[ai][m] = ss[row0 + ai * HALF + m * 16];
        asm volatile("" ::: "memory");
#pragma unroll
        for (int ai = 0; ai < 2; ++ai)
#pragma unroll
            for (int m = 0; m < 4; ++m) { const int row = row0 + ai * HALF + m * 16; const float rs = __builtin_amdgcn_rsqf(rsv[ai][m] * inv_n + eps);
                float a[8];
#pragma unroll
                for (int n = 0; n < 2; ++n)
#pragma unroll
                    for (int i = 0; i < 4; ++i) { const float g = acc[ai][0][m][n][i] * rs, up = acc[ai][1][m][n][i] * rs;
                        a[n * 4 + i] = g * __builtin_amdgcn_rcpf(1.0f + __builtin_amdgcn_exp2f(-1.4426950408889634f * g)) * up; }
                u32x4 w; w.x = cvt_pk_bf16(a[0], a[1]); w.y = cvt_pk_bf16(a[2], a[3]); w.z = cvt_pk_bf16(a[4], a[5]); w.w = cvt_pk_bf16(a[6], a[7]);
                *(u32x4*)(O + (size_t)row * ldc + col0) = w; }
    }
};

template <class Epi, class Sched, bool ALIGN_EPI = false, bool SP2 = false>
__device__ __forceinline__ void gemm_phase(PG8_LAS unsigned char* lds, const Gemm g, const Sched& S, const Epi& E) {
    int tid_ = threadIdx.x; asm volatile("" : "+v"(tid_));
    const int tid = tid_, wid = __builtin_amdgcn_readfirstlane(tid >> 6), lane = tid & 63, wr = wid >> 2, wc = wid & 3, fr = lane & 15, fq = lane >> 4;
    const int K = g.K, nt = K / BK;
    unsigned voffA[2], voffB[2];
#pragma unroll
    for (int i = 0; i < 2; ++i) { int R, C; stage_rc(tid * 16 + i * 8192, R, C); const int Rb = Epi::PERM ? ((R & ~31) + perm32(R & 31)) : R;
        voffA[i] = (unsigned)(R * K + C) * 2u; voffB[i] = (unsigned)(Rb * K + C) * 2u; }
    const size_t kstep = (size_t)(BK * 2);
    const size_t hstep = (size_t)HALF * K * 2;
    const size_t tstep = 2 * hstep;
    const unsigned ldsw = (unsigned)wid * 1024u;
    const int aoff = lds_byte(wr * 64 + fr, fq * 8), boff = lds_byte(wc * 32 + fr, fq * 8);
#define PG8_SA(b, h) (((b) * 2 + (h)) * HTB)
#define PG8_SB(b, h) ((4 + (b) * 2 + (h)) * HTB)
#define PG8_STAGE(bufoff, gbase, voff) do { _Pragma("unroll") for (int _i = 0; _i < 2; ++_i) \
        __builtin_amdgcn_global_load_lds((const unsigned*)((const char*)(gbase) + (voff)[_i]), (PG8_LAS unsigned*)(lds + (bufoff) + ldsw + _i * 8192), 16, 0, 0); } while (0)
#define PG8_LDA(dst, b, h) do { _Pragma("unroll") for (int m = 0; m < 4; ++m) _Pragma("unroll") for (int k = 0; k < 2; ++k) dst[m][k] = *(const PG8_LAS bf16x8*)(lds + PG8_SA(b, h) + aoff + m * 2048 + k * 1024); } while (0)
#define PG8_LDB(dst, b, h) do { _Pragma("unroll") for (int n = 0; n < 2; ++n) _Pragma("unroll") for (int k = 0; k < 2; ++k) dst[n][k] = *(const PG8_LAS bf16x8*)(lds + PG8_SB(b, h) + boff + n * 2048 + k * 1024); } while (0)
#define PG8_MMA(ai, bj, At, Bt) do { __builtin_amdgcn_s_setprio(1); _Pragma("unroll") for (int m = 0; m < 4; ++m) _Pragma("unroll") for (int n = 0; n < 2; ++n) _Pragma("unroll") for (int k = 0; k < 2; ++k) \
        acc[ai][bj][m][n] = __builtin_amdgcn_mfma_f32_16x16x32_bf16(Bt[n][k], At[m][k], acc[ai][bj][m][n], 0, 0, 0); __builtin_amdgcn_s_setprio(0); } while (0)
#define PG8_WAIT_V(n) asm volatile("s_waitcnt vmcnt(" #n ")" ::: "memory")
#define PG8_WAIT_L(n) asm volatile("s_waitcnt lgkmcnt(" #n ")" ::: "memory")
#define PG8_BAR __builtin_amdgcn_s_barrier()
#define PG8_SCHED __builtin_amdgcn_sched_barrier(0)
    Unit cur, nxt; int ui = 0;
    if (!S.next(0, cur)) return;
    f32x4 acc[2][2][4][2];
#pragma unroll
    for (int a = 0; a < 2; ++a)
#pragma unroll
        for (int b = 0; b < 2; ++b)
#pragma unroll
            for (int m = 0; m < 4; ++m)
#pragma unroll
                for (int n = 0; n < 2; ++n) acc[a][b][m][n] = (f32x4){0.f, 0.f, 0.f, 0.f};
    bf16x8 At[4][2], B0[2][2], B1[2][2];
    const char* cA = (const char*)g.A + (size_t)cur.pm * tstep; const char* cB = (const char*)g.Bt + (size_t)cur.pn * tstep;
    S.a_ready(cur);
    if constexpr (SP2) {
        PG8_STAGE(PG8_SB(0, 0), cB, voffB); PG8_STAGE(PG8_SB(0, 1), cB + hstep, voffB); PG8_STAGE(PG8_SA(0, 0), cA, voffA); PG8_STAGE(PG8_SA(0, 1), cA + hstep, voffA);
        if (wr == 1) PG8_BAR;
        PG8_WAIT_V(2); PG8_BAR;
        PG8_STAGE(PG8_SB(1, 0), cB + kstep, voffB); PG8_STAGE(PG8_SA(1, 0), cA + kstep, voffA); PG8_STAGE(PG8_SB(1, 1), cB + hstep + kstep, voffB);
        PG8_WAIT_V(6); PG8_BAR;
    } else {
        PG8_STAGE(PG8_SB(0, 0), cB, voffB); PG8_STAGE(PG8_SA(0, 0), cA, voffA); PG8_STAGE(PG8_SB(0, 1), cB + hstep, voffB); PG8_STAGE(PG8_SA(0, 1), cA + hstep, voffA);
        if (wr == 1) PG8_BAR;
        PG8_WAIT_V(4); PG8_BAR;
        PG8_STAGE(PG8_SB(1, 0), cB + kstep, voffB); PG8_STAGE(PG8_SA(1, 0), cA + kstep, voffA); PG8_STAGE(PG8_SB(1, 1), cB + hstep + kstep, voffB);
        PG8_WAIT_V(6); PG8_BAR;
    }
    for (;;) {
        const bool has_next = S.next(ui + 1, nxt);
        const char* nA = has_next ? (const char*)g.A + (size_t)nxt.pm * tstep : cA; const char* nB = has_next ? (const char*)g.Bt + (size_t)nxt.pn * tstep : cB;
        for (int t = 0; t < nt; t += 2) {
            const bool last = (t == nt - 2);
            const char* a1 = cA + (size_t)(t + 1) * kstep;
            const char* a2 = last ? nA : cA + (size_t)(t + 2) * kstep; const char* b2 = last ? nB : cB + (size_t)(t + 2) * kstep;
            const char* a3 = a2 + kstep; const char* b3 = b2 + kstep;
            if (last && has_next) S.a_ready(nxt);
            if constexpr (SP2) {
            PG8_LDB(B0, 0, 0); PG8_LDB(B1, 0, 1); PG8_SCHED; PG8_LDA(At, 0, 0); PG8_STAGE(PG8_SA(1, 1), a1 + hstep, voffA);
            PG8_WAIT_V(8); PG8_WAIT_L(0); PG8_BAR; PG8_MMA(0, 0, At, B0); PG8_MMA(0, 1, At, B1); PG8_BAR; PG8_SCHED;
            PG8_LDA(At, 0, 1); PG8_STAGE(PG8_SB(0, 0), b2, voffB); PG8_STAGE(PG8_SB(0, 1), b2 + hstep, voffB); PG8_STAGE(PG8_SA(0, 0), a2, voffA);
            PG8_WAIT_V(8); PG8_WAIT_L(0); PG8_BAR; PG8_MMA(1, 0, At, B0); PG8_MMA(1, 1, At, B1); PG8_BAR; PG8_SCHED;
            PG8_LDB(B0, 1, 0); PG8_LDB(B1, 1, 1); PG8_SCHED; PG8_LDA(At, 1, 0); PG8_STAGE(PG8_SA(0, 1), a2 + hstep, voffA);
            PG8_WAIT_V(8); PG8_WAIT_L(0); PG8_BAR; PG8_MMA(0, 0, At, B0); PG8_MMA(0, 1, At, B1); PG8_BAR; PG8_SCHED;
            PG8_LDA(At, 1, 1); PG8_STAGE(PG8_SB(1, 0), b3, voffB); PG8_STAGE(PG8_SB(1, 1), b3 + hstep, voffB); PG8_STAGE(PG8_SA(1, 0), a3, voffA);
            PG8_WAIT_V(8); PG8_WAIT_L(0); PG8_BAR; PG8_MMA(1, 0, At, B0); PG8_MMA(1, 1, At, B1); PG8_BAR; PG8_SCHED;
            } else {
            PG8_LDB(B0, 0, 0); PG8_SCHED; PG8_LDA(At, 0, 0); PG8_STAGE(PG8_SA(1, 1), a1 + hstep, voffA);
            PG8_WAIT_L(8); PG8_BAR; PG8_WAIT_L(0); PG8_MMA(0, 0, At, B0); PG8_BAR; PG8_SCHED;
            PG8_LDB(B1, 0, 1); PG8_STAGE(PG8_SB(0, 0), b2, voffB);
            PG8_BAR; PG8_WAIT_L(0); PG8_MMA(0, 1, At, B1); PG8_BAR;
            PG8_LDA(At, 0, 1); PG8_STAGE(PG8_SA(0, 0), a2, voffA);
            PG8_BAR; PG8_WAIT_L(0); PG8_MMA(1, 0, At, B0); PG8_BAR; PG8_SCHED;
            PG8_STAGE(PG8_SB(0, 1), b2 + hstep, voffB);
            PG8_WAIT_V(6); PG8_BAR; PG8_MMA(1, 1, At, B1); PG8_BAR;
            PG8_LDB(B0, 1, 0); PG8_SCHED; PG8_LDA(At, 1, 0); PG8_STAGE(PG8_SA(0, 1), a2 + hstep, voffA);
            PG8_WAIT_L(8); PG8_BAR; PG8_WAIT_L(0); PG8_MMA(0, 0, At, B0); PG8_BAR; PG8_SCHED;
            PG8_LDB(B1, 1, 1); PG8_STAGE(PG8_SB(1, 0), b3, voffB);
            PG8_BAR; PG8_WAIT_L(0); PG8_MMA(0, 1, At, B1); PG8_BAR;
            PG8_LDA(At, 1, 1); PG8_STAGE(PG8_SA(1, 0), a3, voffA);
            PG8_BAR; PG8_WAIT_L(0); PG8_MMA(1, 0, At, B0); PG8_BAR; PG8_SCHED;
            PG8_STAGE(PG8_SB(1, 1), b3 + hstep, voffB);
            PG8_WAIT_V(6); PG8_BAR; PG8_MMA(1, 1, At, B1); PG8_BAR;
            }
        }
        if constexpr (ALIGN_EPI) { if (wr == 0) PG8_BAR; }
        if constexpr (!Epi::AFTER_DRAIN) { E(acc, cur, wr, wc, fr, fq); S.done(cur); }
        if (!has_next) break;
#pragma unroll
        for (int a = 0; a < 2; ++a)
#pragma unroll
            for (int b = 0; b < 2; ++b)
#pragma unroll
                for (int m = 0; m < 4; ++m)
#pragma unroll
                    for (int n = 0; n < 2; ++n) acc[a][b][m][n] = (f32x4){0.f, 0.f, 0.f, 0.f};
        cur = nxt; cA = nA; cB = nB; ++ui;
        if constexpr (ALIGN_EPI) { if (wr == 1) PG8_BAR; }
    }
    PG8_WAIT_V(0);
    if constexpr (!ALIGN_EPI) { if (wr == 0) PG8_BAR; }
    PG8_BAR;
    if constexpr (Epi::AFTER_DRAIN) { E.fused(acc, cur, wr, wc, fr, fq, lds, wid, lane); S.done(cur); }
#undef PG8_SA
#undef PG8_SB
#undef PG8_STAGE
#undef PG8_LDA
#undef PG8_LDB
#undef PG8_MMA
#undef PG8_WAIT_V
#undef PG8_WAIT_L
#undef PG8_BAR
#undef PG8_SCHED
}
}

namespace fa {
typedef unsigned short bf16_t;
typedef short bf16x8 __attribute__((ext_vector_type(8)));
typedef short s16x4 __attribute__((ext_vector_type(4)));
typedef float f32x16 __attribute__((ext_vector_type(16)));
typedef float f32x4 __attribute__((ext_vector_type(4)));
typedef unsigned u32x4 __attribute__((ext_vector_type(4)));
constexpr int LDQ = 7168, LDO = 2048, SEQ = 2048;
constexpr float SCALE = 0.08838834764831845f;
constexpr float LOG2E = 1.4426950408889634f;
#define SBAR() __builtin_amdgcn_sched_barrier(0)
#define FA_LAS __attribute__((address_space(3)))
template <int NCB> __device__ __forceinline__ int v_st(int k, int c) { const int kk = (k & ~0xC) | ((k & 4) << 1) | ((k & 8) >> 1); return ((kk >> 3) * NCB + (c >> 5)) * 512 + ((kk & 7) * 32 + (c & 31)) * 2; }
__device__ __forceinline__ int v_rd_base(int lane) { return ((lane & 3) << 3) | (((lane >> 2) & 3) << 6) | (((lane >> 4) & 1) << 5) | (((lane >> 5) & 1) << 8); }
__device__ __forceinline__ int crow(int r, int hi) { return (r & 3) + 8 * (r >> 2) + 4 * hi; }
__device__ __forceinline__ unsigned cvtpk(float lo, float hi) { unsigned r; asm volatile("v_cvt_pk_bf16_f32 %0, %1, %2" : "=v"(r) : "v"(lo), "v"(hi)); return r; }
__device__ __forceinline__ float bf2f(bf16_t v) { return __uint_as_float(((unsigned)v) << 16); }

template <int CLS> __device__ __forceinline__ void bias_tile(f32x16& p0, f32x16& p1, int dq, float slr, int dq15, int dq3) {
    const float NEG = -__builtin_inff(); const float L2R = 0.6931471805599453f / SCALE, L3R = 1.0986122886681098f / SCALE;
#pragma unroll
    for (int r = 0; r < 16; ++r) {
#pragma unroll
        for (int hf = 0; hf < 2; ++hf) {
            const int C = (r & 3) + 8 * (r >> 2) + 32 * hf;
            float v = hf ? p1[r] : p0[r];
            v = __builtin_fmaf(slr, (float)C, v);
            const bool m16 = dq15 == (C & 15), m4 = dq3 == (C & 3);
            if (CLS == 2) { v = m16 ? v : NEG; }
            else if (CLS == 1) { const float v2 = v + L2R; v = m16 ? v2 : v; v = m4 ? v : NEG; }
            else if (CLS == 3 || CLS == 4) { float bb = m4 ? L2R : 0.f; bb = m16 ? L3R : bb; v += bb; if (CLS == 4) v = (dq >= C) ? v : NEG; }
            else if (CLS == 5) { const bool n1 = dq <= C + 128; const float b16 = n1 ? L3R : L2R, b4 = n1 ? L2R : 0.f, b1 = n1 ? 0.f : NEG; v += m16 ? b16 : (m4 ? b4 : b1); }
            else { const bool n5 = dq <= C + 512; const float b16 = n5 ? L2R : 0.f, b4 = n5 ? 0.f : NEG; v += m16 ? b16 : (m4 ? b4 : NEG); }
            if (hf) p1[r] = v; else p0[r] = v;
        }
    }
}
constexpr float THR = 8.f;
__device__ __forceinline__ void partialSM(f32x16& p0, f32x16& p1, float& m_reg, float& mn, float& alpha) {
    float pmax = p0[0];
#pragma unroll
    for (int r = 1; r < 16; ++r) pmax = fmaxf(pmax, p0[r]);
#pragma unroll
    for (int r = 0; r < 16; ++r) pmax = fmaxf(pmax, p1[r]);
    { auto rr = __builtin_amdgcn_permlane32_swap(__float_as_uint(pmax), __float_as_uint(pmax), false, false);
      pmax = fmaxf(__uint_as_float(rr[0]), __uint_as_float(rr[1])); }
    constexpr float C2 = LOG2E * SCALE;
    if (__builtin_expect(__all((pmax - m_reg) * SCALE <= THR), 1)) { mn = m_reg; alpha = 1.f; }
    else { mn = fmaxf(m_reg, pmax); alpha = __builtin_amdgcn_exp2f((m_reg - mn) * C2); m_reg = mn; }
    const float mnL = -mn * C2;
#pragma unroll
    for (int r = 0; r < 16; ++r) p0[r] = __builtin_fmaf(p0[r], C2, mnL);
#pragma unroll
    for (int r = 0; r < 16; ++r) p1[r] = __builtin_fmaf(p1[r], C2, mnL);
#pragma unroll
    for (int r = 0; r < 16; ++r) p0[r] = __builtin_amdgcn_exp2f(p0[r]);
#pragma unroll
    for (int r = 0; r < 16; ++r) p1[r] = __builtin_amdgcn_exp2f(p1[r]);
}
#define FA_PK4(P, B_, OUT) do { unsigned a0 = cvtpk(P[B_+0], P[B_+1]), a1 = cvtpk(P[B_+2], P[B_+3]);                          \
        unsigned b0 = cvtpk(P[B_+4], P[B_+5]), b1 = cvtpk(P[B_+6], P[B_+7]);                                             \
        auto r0 = __builtin_amdgcn_permlane32_swap(a0, b0, false, false); auto r1 = __builtin_amdgcn_permlane32_swap(a1, b1, false, false); \
        u32x4 w = {r0[0], r1[0], r0[1], r1[1]}; OUT = *reinterpret_cast<bf16x8*>(&w); } while (0)
__device__ __forceinline__ void pack_p(const f32x16& p0, const f32x16& p1, bf16x8& pa0, bf16x8& pa1, bf16x8& pa2, bf16x8& pa3) {
    FA_PK4(p0, 0, pa0); FA_PK4(p0, 8, pa1); FA_PK4(p1, 0, pa2); FA_PK4(p1, 8, pa3);
}
__device__ __forceinline__ void finishSM(f32x16& p0, f32x16& p1, float alpha, float& l_reg, bf16x8& pa0, bf16x8& pa1, bf16x8& pa2, bf16x8& pa3) {
    float ps = 0;
#pragma unroll
    for (int r = 0; r < 16; ++r) ps += p0[r];
#pragma unroll
    for (int r = 0; r < 16; ++r) ps += p1[r];
    { auto rr = __builtin_amdgcn_permlane32_swap(__float_as_uint(ps), __float_as_uint(ps), false, false);
      ps = __uint_as_float(rr[0]) + __uint_as_float(rr[1]); }
    l_reg = l_reg * alpha + ps;
    pack_p(p0, p1, pa0, pa1, pa2, pa3);
}
template <int NF, int RB>
__device__ __forceinline__ void qkt(f32x16& p0, f32x16& p1, const char* Kt, int r32, int hi, const bf16x8* qr, float init) {
#pragma unroll
    for (int r = 0; r < 16; ++r) { p0[r] = init; p1[r] = init; }
    const char* kb[4];
#pragma unroll
    for (int dd = 0; dd < 4; ++dd) kb[dd] = Kt + r32 * RB + (((dd * 16 + hi * 8) * 2) ^ ((r32 & 7) << 4));
#pragma unroll
    for (int d0 = 0; d0 < NF; ++d0) { const char* a = kb[d0 & 3] + (d0 >> 2) * 128;
        bf16x8 b0 = *reinterpret_cast<const bf16x8*>(a);
        bf16x8 b1 = *reinterpret_cast<const bf16x8*>(a + 32 * RB);
        p0 = __builtin_amdgcn_mfma_f32_32x32x16_bf16(b0, qr[d0], p0, 0, 0, 0);
        p1 = __builtin_amdgcn_mfma_f32_32x32x16_bf16(b1, qr[d0], p1, 0, 0, 0); }
}
template <int NF, int RB>
__device__ __forceinline__ void qkt1(f32x16& p, const char* Kt, int r32, int hi, const bf16x8* qr) {
#pragma unroll
    for (int r = 0; r < 16; ++r) p[r] = 0.f;
    const char* kb[4];
#pragma unroll
    for (int dd = 0; dd < 4; ++dd) kb[dd] = Kt + r32 * RB + (((dd * 16 + hi * 8) * 2) ^ ((r32 & 7) << 4));
#pragma unroll
    for (int d0 = 0; d0 < NF; ++d0) { const bf16x8 b0 = *reinterpret_cast<const bf16x8*>(kb[d0 & 3] + (d0 >> 2) * 128);
        p = __builtin_amdgcn_mfma_f32_32x32x16_bf16(b0, qr[d0], p, 0, 0, 0); }
}
template <int KS, int HF>
__device__ __forceinline__ void pv_tile(f32x16* o, int vb, bf16x8 pa0, bf16x8 pa1, bf16x8 pa2, bf16x8 pa3) {
#define FA_TRRD(dst, off) asm volatile("ds_read_b64_tr_b16 %0, %1 offset:%2" : "=&v"(dst) : "v"(vb), "i"(off) : "memory")
#define FA_PV_D0(d0) do { s16x4 l0, l1, l2, l3, h0, h1, h2, h3; constexpr int b_ = (d0) * 512; \
        FA_TRRD(l0, b_); FA_TRRD(h0, b_ + HF); FA_TRRD(l1, b_ + KS); FA_TRRD(h1, b_ + KS + HF); FA_TRRD(l2, b_ + 2 * KS); FA_TRRD(h2, b_ + 2 * KS + HF); FA_TRRD(l3, b_ + 3 * KS); FA_TRRD(h3, b_ + 3 * KS + HF); \
        asm volatile("s_waitcnt lgkmcnt(0)" ::: "memory"); SBAR();   \
        o[d0] = __builtin_amdgcn_mfma_f32_32x32x16_bf16(pa0, (bf16x8){l0[0], l0[1], l0[2], l0[3], h0[0], h0[1], h0[2], h0[3]}, o[d0], 0, 0, 0);   \
        o[d0] = __builtin_amdgcn_mfma_f32_32x32x16_bf16(pa1, (bf16x8){l1[0], l1[1], l1[2], l1[3], h1[0], h1[1], h1[2], h1[3]}, o[d0], 0, 0, 0);   \
        o[d0] = __builtin_amdgcn_mfma_f32_32x32x16_bf16(pa2, (bf16x8){l2[0], l2[1], l2[2], l2[3], h2[0], h2[1], h2[2], h2[3]}, o[d0], 0, 0, 0);   \
        o[d0] = __builtin_amdgcn_mfma_f32_32x32x16_bf16(pa3, (bf16x8){l3[0], l3[1], l3[2], l3[3], h3[0], h3[1], h3[2], h3[3]}, o[d0], 0, 0, 0); } while (0)
    FA_PV_D0(0); FA_PV_D0(1); FA_PV_D0(2); FA_PV_D0(3);
#undef FA_PV_D0
#undef FA_TRRD
}

__device__ __forceinline__ void attn_block(const bf16_t* __restrict__ proj, bf16_t* __restrict__ mixed, int b, int h, int qb, char* lds) {
    int tid_ = threadIdx.x; asm volatile("" : "+v"(tid_));
    const int tid = tid_, wid = __builtin_amdgcn_readfirstlane(tid >> 6), lane = tid & 63, r32 = lane & 31, hi = lane >> 5;
    constexpr int SHM = 16384;
    char* V_lds = lds; char* K_lds = lds + 2 * SHM;
    float* wsf = (float*)(lds + 65536) + wid * 64; float* li_l = wsf; float* al_l = wsf + 32;
    const bf16_t* Qp = proj + (size_t)(b * SEQ + qb * 256) * LDQ + h * 128;
    const bf16_t* Kp = proj + (size_t)(b * SEQ) * LDQ + 1024 + h * 128;
    const bf16_t* Vp = Kp + 1024;
    bf16_t* Op = mixed + (size_t)(b * SEQ + qb * 256 + wid * 32) * LDO + h * 128;
    const int NT = 4 * (qb + 1);
    const int qlo = qb * 256 + wid * 32, qm = qlo + r32 - 4 * hi;
    const float slr = __builtin_amdgcn_exp2f(-(float)(h + 1)) * (1.0f / SCALE);
    bf16x8 qr[8];
#pragma unroll
    for (int d0 = 0; d0 < 8; ++d0) qr[d0] = *(const bf16x8*)(Qp + (size_t)(wid * 32 + r32) * LDQ + d0 * 16 + hi * 8);
    const int lb = wid * 1024 + lane * 16;
    const int krow = lb >> 8, kch = ((lb >> 4) & 15) ^ (krow & 7);
    const bf16_t* kg = Kp + (size_t)krow * LDQ + kch * 8;
    const int stv = lb >> 9, kkv = ((stv >> 2) << 3) | ((lb >> 6) & 7), kvv = (kkv & ~0xC) | ((kkv & 4) << 1) | ((kkv & 8) >> 1);
    const bf16_t* vg = Vp + (size_t)kvv * LDQ + (stv & 3) * 32 + ((lb >> 4) & 3) * 8;
#define FA_DMA(k0, bf) do { _Pragma("unroll") for (int i_ = 0; i_ < 2; ++i_) { \
        __builtin_amdgcn_global_load_lds((const unsigned*)(kg + (size_t)((k0) + 32 * i_) * LDQ), (FA_LAS unsigned*)(K_lds + (bf) * SHM + i_ * 8192 + wid * 1024), 16, 0, 0); \
        __builtin_amdgcn_global_load_lds((const unsigned*)(vg + (size_t)((k0) + 32 * i_) * LDQ), (FA_LAS unsigned*)(V_lds + (bf) * SHM + i_ * 8192 + wid * 1024), 16, 0, 0); } } while (0)
    FA_DMA(0, 0);
    asm volatile("s_waitcnt vmcnt(0)" ::: "memory");
    __syncthreads();
    float m_reg = -1e30f, l_reg = 0.f; f32x16 o[4];
#pragma unroll
    for (int d = 0; d < 4; ++d)
#pragma unroll
        for (int r = 0; r < 16; ++r) o[d][r] = 0.f;
    const int vb0 = (int)(uintptr_t)V_lds + v_rd_base(lane);
    const int dq15 = qm & 15, dq3 = qm & 3, r0 = (dq15 & 3) + 4 * (dq15 >> 3);
    const bool lane_valid = (dq15 & 4) == 0, r0odd = (r0 & 1) != 0;
    const bool is1 = r0 == 1, is2 = r0 == 2, is3 = r0 == 3, is4 = r0 == 4, is5 = r0 == 5, is6 = r0 == 6, is7 = r0 == 7;
    const bool rp0 = (r0 >> 1) == 0, rp1 = (r0 >> 1) == 1, rp2 = (r0 >> 1) == 2, rp3 = (r0 >> 1) == 3;
    const float fc0 = slr * (float)((r0 & 3) + 8 * (r0 >> 2));
    for (int t = 0; t < NT; ++t) {
        const int buf = t & 1, kb = t * 64;
        if (t + 1 < NT) FA_DMA(kb + 64, buf ^ 1);
        if (kb <= qlo + 31) {
            f32x16 p0, p1; const int dq = qm - kb;
            qkt<8, 256>(p0, p1, K_lds + buf * SHM, r32, hi, qr, -slr * (float)dq);
            const int dmin = qlo - kb - 63, dmax = qlo + 31 - kb;
            float alpha; bf16x8 pa0, pa1, pa2, pa3;
            if (dmin > 512) {
#define FA_SEL8(P, B_) ({ float v_ = P[B_]; v_ = is1 ? P[B_ + 1] : v_; v_ = is2 ? P[B_ + 2] : v_; v_ = is3 ? P[B_ + 3] : v_; v_ = is4 ? P[B_ + 4] : v_; v_ = is5 ? P[B_ + 5] : v_; v_ = is6 ? P[B_ + 6] : v_; v_ = is7 ? P[B_ + 7] : v_; v_; })
                const float NEG = -__builtin_inff();
                float e0 = FA_SEL8(p0, 0) + fc0, e1 = FA_SEL8(p0, 8) + (fc0 + 16.f * slr), e2 = FA_SEL8(p1, 0) + (fc0 + 32.f * slr), e3 = FA_SEL8(p1, 8) + (fc0 + 48.f * slr);
#undef FA_SEL8
                e0 = lane_valid ? e0 : NEG; e1 = lane_valid ? e1 : NEG; e2 = lane_valid ? e2 : NEG; e3 = lane_valid ? e3 : NEG;
                float pmax = fmaxf(fmaxf(e0, e1), fmaxf(e2, e3));
                { auto rr = __builtin_amdgcn_permlane32_swap(__float_as_uint(pmax), __float_as_uint(pmax), false, false); pmax = fmaxf(__uint_as_float(rr[0]), __uint_as_float(rr[1])); }
                constexpr float C2 = LOG2E * SCALE; float mn;
                if (__builtin_expect(__all((pmax - m_reg) * SCALE <= THR), 1)) { mn = m_reg; alpha = 1.f; }
                else { mn = fmaxf(m_reg, pmax); alpha = __builtin_amdgcn_exp2f((m_reg - mn) * C2); m_reg = mn; }
                const float mnL = -mn * C2;
                e0 = __builtin_amdgcn_exp2f(__builtin_fmaf(e0, C2, mnL)); e1 = __builtin_amdgcn_exp2f(__builtin_fmaf(e1, C2, mnL));
                e2 = __builtin_amdgcn_exp2f(__builtin_fmaf(e2, C2, mnL)); e3 = __builtin_amdgcn_exp2f(__builtin_fmaf(e3, C2, mnL));
                float ps = (e0 + e1) + (e2 + e3);
                { auto rr = __builtin_amdgcn_permlane32_swap(__float_as_uint(ps), __float_as_uint(ps), false, false); ps = __uint_as_float(rr[0]) + __uint_as_float(rr[1]); }
                l_reg = l_reg * alpha + ps;
#define FA_SCAT(E_, OUT) do { unsigned w_ = cvtpk(E_, 0.f); w_ = r0odd ? (w_ << 16) : w_; \
                    const unsigned a0 = rp0 ? w_ : 0u, a1 = rp1 ? w_ : 0u, b0 = rp2 ? w_ : 0u, b1 = rp3 ? w_ : 0u; \
                    auto s0 = __builtin_amdgcn_permlane32_swap(a0, b0, false, false); auto s1 = __builtin_amdgcn_permlane32_swap(a1, b1, false, false); \
                    u32x4 ww = {s0[0], s1[0], s0[1], s1[1]}; OUT = *reinterpret_cast<bf16x8*>(&ww); } while (0)
                FA_SCAT(e0, pa0); FA_SCAT(e1, pa1); FA_SCAT(e2, pa2); FA_SCAT(e3, pa3);
#undef FA_SCAT
            } else {
                if (dmin < 0) bias_tile<4>(p0, p1, dq, slr, dq15, dq3);
                else if (dmax <= 128) bias_tile<3>(p0, p1, dq, slr, dq15, dq3);
                else if (dmin <= 128) bias_tile<5>(p0, p1, dq, slr, dq15, dq3);
                else if (dmax <= 512) bias_tile<1>(p0, p1, dq, slr, dq15, dq3);
                else bias_tile<6>(p0, p1, dq, slr, dq15, dq3);
                float mn; partialSM(p0, p1, m_reg, mn, alpha);
                finishSM(p0, p1, alpha, l_reg, pa0, pa1, pa2, pa3);
            }
            if (__any(alpha < 1.f)) { if (hi == 0) al_l[r32] = alpha; asm volatile("s_waitcnt lgkmcnt(0)" ::: "memory");
#pragma unroll
                for (int d_ = 0; d_ < 4; ++d_)
#pragma unroll
                    for (int r = 0; r < 16; ++r) o[d_][r] *= al_l[crow(r, hi)]; }
            pv_tile<4096, 2048>(o, vb0 + buf * SHM, pa0, pa1, pa2, pa3);
        }
        asm volatile("s_waitcnt vmcnt(0)" ::: "memory");
        __syncthreads();
    }
#undef FA_DMA
    if (hi == 0) li_l[r32] = l_reg; asm volatile("s_waitcnt lgkmcnt(0)" ::: "memory");
#pragma unroll
    for (int r = 0; r < 16; ++r) { const int orow = crow(r, hi); const float rl = __builtin_amdgcn_rcpf(li_l[orow]);
#pragma unroll
        for (int d0 = 0; d0 < 4; ++d0) { const float v = o[d0][r] * rl; const float vn = __shfl_xor(v, 1);
            if ((r32 & 1) == 0) *(unsigned*)(Op + (size_t)orow * LDO + d0 * 32 + r32) = cvtpk(v, vn); } }
    __syncthreads();
}

__device__ __forceinline__ void ret_state_scan(const bf16_t* __restrict__ proj, bf16_t* __restrict__ state, int b, int h, int d4, int e2, char* lds) {
    int tid_ = threadIdx.x; asm volatile("" : "+v"(tid_));
    const int tid = tid_, wid = __builtin_amdgcn_readfirstlane(tid >> 6), lane = tid & 63, r32 = lane & 31, hi = lane >> 5;
    const int wd = wid & 1, we = wid >> 1;
    constexpr int STG = 24576;
    const bf16_t* Kp = proj + (size_t)(b * SEQ) * LDQ + 4096 + h * 256 + d4 * 64;
    const bf16_t* Vp = proj + (size_t)(b * SEQ) * LDQ + 5120 + h * 256 + e2 * 128;
    bf16_t* Sp = state + ((size_t)((b * 4 + h) * 16) * 256 + d4 * 64 + wd * 32) * 256 + e2 * 128 + we * 32;
    const int lb = wid * 1024 + lane * 16, stv = lb >> 9, rowin = (lb >> 6) & 7, ch = (lb >> 4) & 3;
    const int kkk = ((stv >> 1) << 3) | rowin, keyk = (kkk & ~0xC) | ((kkk & 4) << 1) | ((kkk & 8) >> 1);
    const bf16_t* kg = Kp + (size_t)keyk * LDQ + (stv & 1) * 32 + ch * 8;
    const int kkv = ((stv >> 2) << 3) | rowin, keyv = (kkv & ~0xC) | ((kkv & 4) << 1) | ((kkv & 8) >> 1);
    const bf16_t* vg = Vp + (size_t)keyv * LDQ + (stv & 3) * 32 + ch * 8;
#define FA_DMA(st_, sg_) do { char* base_ = lds + (sg_) * STG; const size_t k0_ = (size_t)(st_) * 64 * LDQ; \
        __builtin_amdgcn_global_load_lds((const unsigned*)(kg + k0_), (FA_LAS unsigned*)(base_ + wid * 1024), 16, 0, 0); \
        __builtin_amdgcn_global_load_lds((const unsigned*)(vg + k0_), (FA_LAS unsigned*)(base_ + 8192 + wid * 1024), 16, 0, 0); \
        __builtin_amdgcn_global_load_lds((const unsigned*)(vg + k0_ + (size_t)32 * LDQ), (FA_LAS unsigned*)(base_ + 16384 + wid * 1024), 16, 0, 0); } while (0)
    f32x16 R;
#pragma unroll
    for (int r = 0; r < 16; ++r) R[r] = 0.f;
    const int rb = (int)(uintptr_t)lds + v_rd_base(lane);
    FA_DMA(0, 0); FA_DMA(1, 1);
    for (int st = 0; st < 32; ++st) {
        if ((st & 1) == 0 && st > 0) {
            bf16_t* dst = Sp + (size_t)(st >> 1) * 65536;
#pragma unroll
            for (int r = 0; r < 16; ++r) { const float v = R[r]; const float vn = __shfl_xor(v, 1);
                if ((r32 & 1) == 0) *(unsigned*)(dst + (size_t)crow(r, hi) * 256 + r32) = cvtpk(v, vn); } }
        if (st + 2 < 32) { FA_DMA(st + 2, (st + 2) & 3); asm volatile("s_waitcnt vmcnt(6)" ::: "memory"); }
        else asm volatile("s_waitcnt vmcnt(0)" ::: "memory");
        __builtin_amdgcn_s_barrier(); asm volatile("" ::: "memory");
        const int ka = rb + (st & 3) * STG + wd * 512, va = rb + (st & 3) * STG + 8192 + we * 512;
#define FA_TR(dst, base, off) asm volatile("ds_read_b64_tr_b16 %0, %1 offset:%2" : "=&v"(dst) : "v"(base), "i"(off) : "memory")
        s16x4 al[4], ah[4], bl[4], bh[4];
        FA_TR(al[0], ka, 0); FA_TR(ah[0], ka, 1024); FA_TR(al[1], ka, 2048); FA_TR(ah[1], ka, 3072); FA_TR(al[2], ka, 4096); FA_TR(ah[2], ka, 5120); FA_TR(al[3], ka, 6144); FA_TR(ah[3], ka, 7168);
        FA_TR(bl[0], va, 0); FA_TR(bh[0], va, 2048); FA_TR(bl[1], va, 4096); FA_TR(bh[1], va, 6144); FA_TR(bl[2], va, 8192); FA_TR(bh[2], va, 10240); FA_TR(bl[3], va, 12288); FA_TR(bh[3], va, 14336);
        asm volatile("s_waitcnt lgkmcnt(0)" ::: "memory"); SBAR();
#pragma unroll
        for (int ks = 0; ks < 4; ++ks)
            R = __builtin_amdgcn_mfma_f32_32x32x16_bf16((bf16x8){al[ks][0], al[ks][1], al[ks][2], al[ks][3], ah[ks][0], ah[ks][1], ah[ks][2], ah[ks][3]},
                                                        (bf16x8){bl[ks][0], bl[ks][1], bl[ks][2], bl[ks][3], bh[ks][0], bh[ks][1], bh[ks][2], bh[ks][3]}, R, 0, 0, 0);
#undef FA_TR
    }
#undef FA_DMA
    __syncthreads();
}

__device__ __forceinline__ void ret_block(const bf16_t* __restrict__ proj, const bf16_t* __restrict__ state, bf16_t* __restrict__ mixed, int b, int h, int qb, char* lds) {
    int tid_ = threadIdx.x; asm volatile("" : "+v"(tid_));
    const int tid = tid_, wid = __builtin_amdgcn_readfirstlane(tid >> 6), lane = tid & 63, r32 = lane & 31, hi = lane >> 5;
    const int wq = wid & 3, e = wid >> 2;
    constexpr int SHM = 32768;
    char* V_lds = lds; char* K_lds = lds + 2 * SHM; float* ssx = (float*)(lds + 131072);
    const bf16_t* Qp = proj + (size_t)(b * SEQ + qb * 128) * LDQ + 3072 + h * 256;
    const bf16_t* Kp = proj + (size_t)(b * SEQ + qb * 128) * LDQ + 4096 + h * 256;
    const bf16_t* Vp = Kp + 1024;
    const bf16_t* Gp = Qp + 3072 + (size_t)(wq * 32) * LDQ + e * 128;
    const bf16_t* Sp = state + (size_t)((b * 4 + h) * 16 + qb) * 65536;
    bf16_t* Op = mixed + (size_t)(b * SEQ + qb * 128 + wq * 32) * LDO + 1024 + h * 256 + e * 128;
    const int qlo = wq * 32, qm = qlo + r32 - 4 * hi;
    bf16x8 qr[16];
#pragma unroll
    for (int d0 = 0; d0 < 16; ++d0) qr[d0] = *(const bf16x8*)(Qp + (size_t)(wq * 32 + r32) * LDQ + d0 * 16 + hi * 8);
    const int lb = wid * 1024 + lane * 16;
    const int krow = lb >> 9, kch = ((lb >> 4) & 31) ^ (krow & 7);
    const bf16_t* kg = Kp + (size_t)krow * LDQ + kch * 8;
    const int stv = lb >> 9, kkv = ((stv >> 3) << 3) | ((lb >> 6) & 7), kvv = (kkv & ~0xC) | ((kkv & 4) << 1) | ((kkv & 8) >> 1);
    const bf16_t* vg = Vp + (size_t)kvv * LDQ + (stv & 7) * 32 + ((lb >> 4) & 3) * 8;
    const bf16_t* sg = Sp + (size_t)kvv * 256 + (stv & 7) * 32 + ((lb >> 4) & 3) * 8;
#define FA_DMA(k0, bf) do { _Pragma("unroll") for (int i_ = 0; i_ < 4; ++i_) { \
        __builtin_amdgcn_global_load_lds((const unsigned*)(kg + (size_t)((k0) + 16 * i_) * LDQ), (FA_LAS unsigned*)(K_lds + (bf) * SHM + i_ * 8192 + wid * 1024), 16, 0, 0); \
        __builtin_amdgcn_global_load_lds((const unsigned*)(vg + (size_t)((k0) + 16 * i_) * LDQ), (FA_LAS unsigned*)(V_lds + (bf) * SHM + i_ * 8192 + wid * 1024), 16, 0, 0); } } while (0)
#define FA_DMAS(j_, bf) do { _Pragma("unroll") for (int i_ = 0; i_ < 4; ++i_) \
        __builtin_amdgcn_global_load_lds((const unsigned*)(sg + (size_t)(64 * (j_) + 16 * i_) * 256), (FA_LAS unsigned*)(V_lds + (bf) * SHM + i_ * 8192 + wid * 1024), 16, 0, 0); } while (0)
#define FA_BAR() do { __builtin_amdgcn_s_barrier(); asm volatile("" ::: "memory"); } while (0)
#define FA_DMASX(j_, dstp) do { _Pragma("unroll") for (int i_ = 0; i_ < 4; ++i_) \
        __builtin_amdgcn_global_load_lds((const unsigned*)(sg + (size_t)(64 * (j_) + 16 * i_) * 256), (FA_LAS unsigned*)((dstp) + i_ * 8192 + wid * 1024), 16, 0, 0); } while (0)
    FA_DMA(0, 0); FA_DMA(64, 1);
    f32x16 o[4];
#pragma unroll
    for (int d = 0; d < 4; ++d)
#pragma unroll
        for (int r = 0; r < 16; ++r) o[d][r] = 0.f;
    const int vrd = v_rd_base(lane) + e * 2048;
    const int vbV = (int)(uintptr_t)V_lds + vrd, vbK = (int)(uintptr_t)K_lds + vrd;
    const bool has_state = qb > 0;
    asm volatile("s_waitcnt vmcnt(8)" ::: "memory"); FA_BAR();
#pragma unroll
    for (int t = 0; t < 2; ++t) {
        const int buf = t, kb = t * 64;
        if (kb <= qlo + 31) {
            const bool diag = kb + 63 > qlo; const int dq = qm - kb;
            bf16x8 pa0, pa1, pa2, pa3;
            { f32x16 p; qkt1<16, 512>(p, K_lds + buf * SHM, r32, hi, qr);
              if (diag) {
#pragma unroll
                  for (int r = 0; r < 16; ++r) { const int C = (r & 3) + 8 * (r >> 2); if (dq - C < 0) p[r] = 0.f; } }
              FA_PK4(p, 0, pa0); FA_PK4(p, 8, pa1); }
            { f32x16 p; qkt1<16, 512>(p, K_lds + buf * SHM + 32 * 512, r32, hi, qr);
              if (diag) {
#pragma unroll
                  for (int r = 0; r < 16; ++r) { const int C = (r & 3) + 8 * (r >> 2) + 32; if (dq - C < 0) p[r] = 0.f; } }
              FA_PK4(p, 0, pa2); FA_PK4(p, 8, pa3); }
            pv_tile<8192, 4096>(o, vbV + buf * SHM, pa0, pa1, pa2, pa3);
        }
        if (t == 0) {
            asm volatile("s_waitcnt lgkmcnt(0)" ::: "memory"); FA_BAR();
            if (has_state) { FA_DMASX(0, V_lds); FA_DMASX(1, K_lds); asm volatile("s_waitcnt vmcnt(8)" ::: "memory"); }
            else asm volatile("s_waitcnt vmcnt(0)" ::: "memory");
            FA_BAR();
        }
    }
    if (has_state) {
        asm volatile("s_waitcnt lgkmcnt(0)" ::: "memory"); FA_BAR();
        FA_DMASX(2, V_lds + SHM); FA_DMASX(3, K_lds + SHM);
        asm volatile("s_waitcnt vmcnt(12)" ::: "memory"); FA_BAR();
        pv_tile<8192, 4096>(o, vbV, qr[0], qr[1], qr[2], qr[3]);
        asm volatile("s_waitcnt vmcnt(8)" ::: "memory"); FA_BAR();
        pv_tile<8192, 4096>(o, vbK, qr[4], qr[5], qr[6], qr[7]);
        asm volatile("s_waitcnt vmcnt(4)" ::: "memory"); FA_BAR();
        pv_tile<8192, 4096>(o, vbV + SHM, qr[8], qr[9], qr[10], qr[11]);
        asm volatile("s_waitcnt vmcnt(0)" ::: "memory"); FA_BAR();
        pv_tile<8192, 4096>(o, vbK + SHM, qr[12], qr[13], qr[14], qr[15]);
    }
#undef FA_BAR
#undef FA_DMASX
#undef FA_DMA
#undef FA_DMAS
    bf16_t graw[16][4];
#pragma unroll
    for (int r = 0; r < 16; ++r)
#pragma unroll
        for (int d0 = 0; d0 < 4; ++d0) graw[r][d0] = Gp[(size_t)crow(r, hi) * LDQ + d0 * 32 + r32];
    float ssr[16];
#pragma unroll
    for (int r = 0; r < 16; ++r) { float s = 0.f;
#pragma unroll
        for (int d0 = 0; d0 < 4; ++d0) s += o[d0][r] * o[d0][r];
        s += __shfl_xor(s, 1); s += __shfl_xor(s, 2); s += __shfl_xor(s, 4); s += __shfl_xor(s, 8); s += __shfl_xor(s, 16);
        ssr[r] = s; }
    if (r32 == 0) {
#pragma unroll
        for (int r = 0; r < 16; ++r) ssx[e * 128 + wq * 32 + crow(r, hi)] = ssr[r]; }
    __syncthreads();
#pragma unroll
    for (int r = 0; r < 16; ++r) { const int orow = crow(r, hi); const float tot = ssx[wq * 32 + orow] + ssx[128 + wq * 32 + orow];
        const float rs = __builtin_amdgcn_rsqf(tot * (1.0f / 256.0f) + 1e-6f);
#pragma unroll
        for (int d0 = 0; d0 < 4; ++d0) { const float g = bf2f(graw[r][d0]);
            const float v = o[d0][r] * rs * g * __builtin_amdgcn_rcpf(1.0f + __builtin_amdgcn_exp2f(-LOG2E * g)); const float vn = __shfl_xor(v, 1);
            if ((r32 & 1) == 0) *(unsigned*)(Op + (size_t)orow * LDO + d0 * 32 + r32) = cvtpk(v, vn); } }
    __syncthreads();
}
#undef SBAR
}

#ifndef MK_N_LAUNCHES
#define MK_N_LAUNCHES 1
#endif
constexpr int NWAVES = 8, NPHASE = 8;
constexpr int BATCH = 8, SEQ = 2048, DM = 2048, M = BATCH * SEQ, NPROJ = 7168, FF = 5632, NGU = 2 * FF;
constexpr float NORM_EPS = 1e-6f;
constexpr size_t MiB = 1u << 20;
constexpr size_t WS_SS = 0, WS_BAR = 131072, CTL_ZERO_BYTES = 196608;
constexpr size_t WS_WIN = 1 * MiB, WS_WOUT = 29 * MiB, WS_WGU = 37 * MiB, WS_WDN = 81 * MiB;
constexpr size_t WS_H = 104 * MiB;
constexpr size_t WS_PROJ = 168 * MiB;
constexpr size_t WS_MIXED = 392 * MiB, WS_END = 456 * MiB;
constexpr int RING_BYTES = 131072, LDS_BYTES = 135168;

typedef unsigned short bf16;
typedef unsigned v4u __attribute__((ext_vector_type(4)));
typedef unsigned v2u __attribute__((ext_vector_type(2)));
typedef float f32x4 __attribute__((ext_vector_type(4)));
#define LAS __attribute__((address_space(3)))
__device__ __forceinline__ unsigned f2bf(float f) { unsigned u = __builtin_bit_cast(unsigned, f); return (u + 0x7fffu + ((u >> 16) & 1u)) >> 16; }
__device__ __forceinline__ unsigned pk2(float lo, float hi) { return f2bf(lo) | (f2bf(hi) << 16); }
__device__ __forceinline__ float wave_sum(float v) {
#pragma unroll
    for (int o = 1; o < 64; o <<= 1) v += __shfl_xor(v, o);
    return v;
}
#define XB_TMO      128
#define XB_XCNT(j)  (256  + 64 * (j))
#define XB_XSUB(j)  (1280 + 64 * (j))
#define XB_XGEN(j)  (2304 + 64 * (j))
#define XB_TOP      3328
#define XB_TOPGEN   3392
#define XCD_BAR_WORDS 3456
#define XB_SPIN_CAP (1u << 18)

__device__ __forceinline__ unsigned xb_ld(unsigned* p)              { return __hip_atomic_load(p, __ATOMIC_RELAXED, __HIP_MEMORY_SCOPE_AGENT); }
__device__ __forceinline__ unsigned xb_add(unsigned* p, unsigned v) { return __hip_atomic_fetch_add(p, v, __ATOMIC_RELAXED, __HIP_MEMORY_SCOPE_AGENT); }
__device__ __forceinline__ unsigned xb_xcc_id() { return (unsigned)__builtin_amdgcn_s_getreg((3 << 11) | 20) & 0xFu; }
#define XB_SPIN(cond, bar) do { unsigned _sp = 0; while (cond) { __builtin_amdgcn_s_sleep(1); \
    if ((++_sp & 255u) == 0u) { if (xb_ld(&(bar)[XB_TMO])) break; if (_sp > XB_SPIN_CAP) { atomicAdd(&(bar)[XB_TMO], 1u); break; } } } } while (0)

struct XcdBarrier {
    unsigned* bar; unsigned x;
    volatile LAS unsigned* st;
};

__device__ __forceinline__ XcdBarrier xcd_barrier_post(unsigned* bar, volatile LAS unsigned* st) {
    XcdBarrier b; b.bar = bar; b.x = xb_xcc_id(); b.st = st;
    if (threadIdx.x == 0) (void)xb_add(&bar[XB_XCNT(b.x)], 1u);
    return b;
}
__device__ __forceinline__ void xcd_barrier_complete(unsigned* bar, unsigned x, unsigned& nloc, unsigned& nx) {
    const unsigned G = gridDim.x * gridDim.y * gridDim.z;
    unsigned sum, cnt, mine, sp = 0u;
    for (;;) {
        sum = 0u; cnt = 0u; mine = 0u;
#pragma unroll
        for (unsigned j = 0; j < 16; ++j) { const unsigned c = xb_ld(&bar[XB_XCNT(j)]); sum += c; cnt += (c > 0u) ? 1u : 0u; mine = (j == x) ? c : mine; }
        if (sum == G) break;
        __builtin_amdgcn_s_sleep(1);
        if ((++sp & 255u) == 0u) { if (xb_ld(&bar[XB_TMO])) break; if (sp > XB_SPIN_CAP) { atomicAdd(&bar[XB_TMO], 1u); break; } }
    }
    nloc = mine > 0u ? mine : 1u; nx = cnt > 0u ? cnt : 1u;
}

__device__ __forceinline__ void xcd_barrier(const XcdBarrier& b) {
    asm volatile("s_waitcnt vmcnt(0)" ::: "memory");
    __syncthreads();
    if (threadIdx.x == 0) {
        unsigned* bar = b.bar;
        __builtin_amdgcn_s_waitcnt(0);
        unsigned nloc = b.st[0], nx = b.st[1];
        if (nloc == 0u) { xcd_barrier_complete(bar, b.x, nloc, nx); b.st[0] = nloc; b.st[1] = nx; }
        const unsigned old = xb_add(&bar[XB_XSUB(b.x)], 1u);
        const unsigned gen = old / nloc;
        if (old + 1u == (gen + 1u) * nloc) {
            __builtin_amdgcn_fence(__ATOMIC_RELEASE, "agent");
            asm volatile("s_waitcnt vmcnt(0)" ::: "memory");
            const unsigned og = xb_add(&bar[XB_TOP], 1u);
            const unsigned tg = og / nx;
            if (og + 1u == (tg + 1u) * nx) xb_add(&bar[XB_TOPGEN], 1u);
            else XB_SPIN(xb_ld(&bar[XB_TOPGEN]) == tg, bar);
            __builtin_amdgcn_fence(__ATOMIC_ACQUIRE, "agent");
            xb_add(&bar[XB_XGEN(b.x)], 1u);
            asm volatile("s_waitcnt vmcnt(0)" ::: "memory");
        } else {
            XB_SPIN(xb_ld(&bar[XB_XGEN(b.x)]) == gen, bar);
            __builtin_amdgcn_fence(__ATOMIC_ACQUIRE, "agent");
            asm volatile("s_waitcnt vmcnt(0)" ::: "memory");
        }
    }
    __syncthreads();
}

__device__ __forceinline__ unsigned cvtpk2(float lo, float hi) { unsigned r; asm volatile("v_cvt_pk_bf16_f32 %0, %1, %2" : "=v"(r) : "v"(lo), "v"(hi)); return r; }
__device__ __forceinline__ void p0_transpose_item(const float* __restrict__ W, int K, int N, bf16* __restrict__ WT, int mode, const float* __restrict__ kscale, int item, int lane) {
    const int nblk = N / 64, kb = item / nblk, nb = item % nblk, k0 = 64 * kb, n0 = 64 * nb;
    const float* src = W + (size_t)k0 * N + n0 + lane;
    float v[64];
#pragma unroll
    for (int i = 0; i < 64; ++i) v[i] = src[(size_t)i * N];
    if (kscale) {
#pragma unroll
        for (int i = 0; i < 64; ++i) v[i] *= kscale[k0 + i]; }
    const int rbase = (mode == 0) ? n0 : (256 * (n0 >> 7) + (n0 & 127) + (mode == 2 ? 128 : 0));
    bf16* dst = WT + (size_t)(rbase + lane) * K + k0;
#pragma unroll
    for (int j = 0; j < 8; ++j) { v4u o; o.x = cvtpk2(v[8 * j], v[8 * j + 1]); o.y = cvtpk2(v[8 * j + 2], v[8 * j + 3]); o.z = cvtpk2(v[8 * j + 4], v[8 * j + 5]); o.w = cvtpk2(v[8 * j + 6], v[8 * j + 7]);
        *(v4u*)(dst + 8 * j) = o; }
}

struct ConvOrder : pg8::StaticOrder {
    const float *w_out, *w_gate, *w_up, *w_down, *kscale; bf16 *Wout_t, *Wgu_t, *Wdn_t; int gw, ngw; mutable int nxt;
    static constexpr int I_OUT = (DM / 64) * (DM / 64), I_G = (DM / 64) * (FF / 64), I_DN = (FF / 64) * (DM / 64), NITEMS = I_OUT + 2 * I_G + I_DN;
    __device__ __forceinline__ void convert(int r, int lane) const {
        if (r < I_OUT) { p0_transpose_item(w_out, DM, DM, Wout_t, 0, nullptr, r, lane); return; } r -= I_OUT;
        if (r < I_G) { p0_transpose_item(w_gate, DM, FF, Wgu_t, 1, kscale, r, lane); return; } r -= I_G;
        if (r < I_G) { p0_transpose_item(w_up, DM, FF, Wgu_t, 2, kscale, r, lane); return; } r -= I_G;
        p0_transpose_item(w_down, FF, DM, Wdn_t, 0, nullptr, r, lane);
    }
    __device__ __forceinline__ void done(const pg8::Unit&) const {
        if (nxt < NITEMS) { convert(nxt, (int)(threadIdx.x & 63)); nxt += ngw; asm volatile("s_waitcnt vmcnt(0)" ::: "memory"); }
    }
    __device__ __forceinline__ void finish() const { while (nxt < NITEMS) { convert(nxt, (int)(threadIdx.x & 63)); nxt += ngw; } }
};

struct Args { const float* in[9]; float* out; unsigned char* ws; int ph_lo, ph_hi; };
__global__ void __launch_bounds__(NWAVES * 64, 2) hybrid_fwd(Args args) {
    extern __shared__ __attribute__((aligned(16))) unsigned char lds[];
    cg::grid_group grid = cg::this_grid();
    const int tid = threadIdx.x, lane = tid & 63, wave = __builtin_amdgcn_readfirstlane(tid >> 6);
    const int G = gridDim.x, bx = blockIdx.x, vcu = (G % 8 == 0) ? (bx % 8) * (G / 8) + bx / 8 : bx;
    const float* x = args.in[0]; const float* norm_mix_w = args.in[1]; const float* w_in = args.in[2]; const float* w_out = args.in[3]; const float* norm_ffn_w = args.in[4];
    const float* w_gate = args.in[5]; const float* w_up = args.in[6]; const float* w_down = args.in[7]; const float* norm_final_w = args.in[8];
    float* out = args.out; unsigned char* ws = args.ws;
    float* SS1 = (float*)(ws + WS_SS); float* SS2 = SS1 + M;
    bf16* Win_t = (bf16*)(ws + WS_WIN); bf16* Wout_t = (bf16*)(ws + WS_WOUT); bf16* Wgu_t = (bf16*)(ws + WS_WGU); bf16* Wdn_t = (bf16*)(ws + WS_WDN);
    bf16* HB = (bf16*)(ws + WS_H); bf16* PROJ = (bf16*)(ws + WS_PROJ); bf16* ACT = (bf16*)(ws + WS_PROJ); bf16* MIXED = (bf16*)(ws + WS_MIXED);
    const int lo = args.ph_lo, hi = args.ph_hi;
#define IN(k) (lo <= (k) && (k) < hi)
    volatile LAS unsigned* MISC = (volatile LAS unsigned*)((LAS unsigned char*)lds + LDS_BYTES - 64);
    if (tid < 16) MISC[tid] = 0u;
    __syncthreads();
    XcdBarrier bar = xcd_barrier_post((unsigned*)(ws + WS_BAR), MISC);
    if (hi > 1000) grid.sync();
#define GRID_BAR(k) do { if (IN(k) && IN((k) + 1)) xcd_barrier(bar); } while (0)
    const int gw = vcu * NWAVES + wave, NGW = G * NWAVES;

    if (IN(0)) {
        constexpr int I_IN = (DM / 64) * (NPROJ / 64);
        for (int it = gw; it < I_IN; it += NGW) p0_transpose_item(w_in, DM, NPROJ, Win_t, 0, nullptr, it, lane);
        f32x4 wmix[8];
#pragma unroll
        for (int j = 0; j < 8; ++j) wmix[j] = ((const f32x4*)norm_mix_w + lane)[64 * j];
        for (int m0 = gw * 4; m0 < M; m0 += NGW * 4) {
            f32x4 v[4][8]; float s[4] = {0.f, 0.f, 0.f, 0.f};
#pragma unroll
            for (int q = 0; q < 4; ++q) { const f32x4* xr = (const f32x4*)(x + (size_t)(m0 + q) * DM) + lane;
#pragma unroll
                for (int j = 0; j < 8; ++j) v[q][j] = xr[64 * j]; }
#pragma unroll
            for (int q = 0; q < 4; ++q)
#pragma unroll
                for (int j = 0; j < 8; ++j) s[q] += (v[q][j].x * v[q][j].x + v[q][j].y * v[q][j].y) + (v[q][j].z * v[q][j].z + v[q][j].w * v[q][j].w);
#pragma unroll
            for (int q = 0; q < 4; ++q) { const float rs = __builtin_amdgcn_rsqf(wave_sum(s[q]) * (1.f / DM) + NORM_EPS);
                v2u* o8 = (v2u*)(HB + (size_t)(m0 + q) * DM) + lane;
#pragma unroll
                for (int j = 0; j < 8; ++j) { const f32x4 w = wmix[j]; v2u o; o.x = cvtpk2(v[q][j].x * rs * w.x, v[q][j].y * rs * w.y); o.y = cvtpk2(v[q][j].z * rs * w.z, v[q][j].w * rs * w.w); o8[64 * j] = o; } }
        }
    }
    GRID_BAR(0);

    if (IN(1)) {
        pg8::Gemm g{HB, Win_t, M, NPROJ, DM}; ConvOrder S; S.init(M, NPROJ, G, bx, 8);
        S.w_out = w_out; S.w_gate = w_gate; S.w_up = w_up; S.w_down = w_down; S.kscale = norm_ffn_w; S.Wout_t = Wout_t; S.Wgu_t = Wgu_t; S.Wdn_t = Wdn_t; S.gw = gw; S.ngw = NGW; S.nxt = gw;
        pg8::EpiProj E{PROJ, NPROJ};
        pg8::gemm_phase<pg8::EpiProj, ConvOrder, true, true>((LAS unsigned char*)lds, g, S, E);
        S.finish();
    }
    GRID_BAR(1);

    if (IN(2)) {
        for (int it = vcu; it < 256; it += G) fa::ret_state_scan(PROJ, HB, it >> 5, (it >> 3) & 3, (it >> 1) & 3, it & 1, (char*)lds);
    }
    GRID_BAR(2);

    if (IN(3)) {
        for (int it = vcu; it < 256; it += G) { const int bh = it >> 2, s = it & 3;
#pragma unroll 1
            for (int ps = 0; ps < 2; ++ps) fa::attn_block(PROJ, MIXED, bh >> 3, bh & 7, ps ? s : 7 - s, (char*)lds); }
        for (int it = vcu; it < 256; it += G) { const int bh = it >> 3, s = it & 7;
#pragma unroll 1
            for (int ps = 0; ps < 2; ++ps) fa::ret_block(PROJ, HB, MIXED, bh >> 2, bh & 3, ps ? s : 15 - s, (char*)lds); }
    }
    GRID_BAR(3);

    if (IN(4)) {
        pg8::Gemm g{MIXED, Wout_t, M, DM, DM}; pg8::StaticOrder S; S.init(M, DM, G, bx);
        pg8::EpiRes<false> E{x, HB, SS1, DM};
        pg8::gemm_phase<pg8::EpiRes<false>, pg8::StaticOrder, true, true>((LAS unsigned char*)lds, g, S, E);
    }
    GRID_BAR(4);

    if (IN(5)) {
        pg8::Gemm g{HB, Wgu_t, M, NGU, DM}; pg8::StaticOrder S; S.init(M, NGU, G, bx, 8);
        pg8::EpiGU E{ACT, FF, SS1, 1.f / DM, NORM_EPS};
        pg8::gemm_phase<pg8::EpiGU, pg8::StaticOrder, true, true>((LAS unsigned char*)lds, g, S, E);
    }
    GRID_BAR(5);

    if (IN(6)) {
        pg8::Gemm g{ACT, Wdn_t, M, DM, FF}; pg8::StaticOrder S; S.init(M, DM, G, bx);
        pg8::EpiRes<true> E{HB, MIXED, SS2, DM};
        pg8::gemm_phase<pg8::EpiRes<true>, pg8::StaticOrder, true, true>((LAS unsigned char*)lds, g, S, E);
    }
    GRID_BAR(6);

    if (IN(7)) {
        f32x4 wfin[8];
#pragma unroll
        for (int j = 0; j < 8; ++j) wfin[j] = ((const f32x4*)norm_final_w + lane)[64 * j];
        for (int m0 = gw * 4; m0 < M; m0 += NGW * 4) {
            v2u r[4][8]; float rs[4];
#pragma unroll
            for (int q = 0; q < 4; ++q) { const v2u* xr = (const v2u*)(MIXED + (size_t)(m0 + q) * DM) + lane; rs[q] = __builtin_amdgcn_rsqf(SS2[m0 + q] * (1.f / DM) + NORM_EPS);
#pragma unroll
                for (int j = 0; j < 8; ++j) r[q][j] = xr[64 * j]; }
#pragma unroll
            for (int q = 0; q < 4; ++q) { f32x4* orow = (f32x4*)(out + (size_t)(m0 + q) * DM) + lane;
#pragma unroll
                for (int j = 0; j < 8; ++j) { const f32x4 w = wfin[j]; const float s = rs[q];
                    orow[64 * j] = (f32x4){__uint_as_float(r[q][j].x << 16) * s * w.x, __uint_as_float(r[q][j].x & 0xffff0000u) * s * w.y, __uint_as_float(r[q][j].y << 16) * s * w.z, __uint_as_float(r[q][j].y & 0xffff0000u) * s * w.w}; } }
        }
    }
#undef IN
#undef GRID_BAR
}

extern "C" void kernel_launch(void* const* d_in, const int* in_sizes, int n_in, void* d_out, int out_size, void* d_ws, size_t ws_size, hipStream_t stream) {
    static int grid = 0;
    if (grid == 0) {
        if (n_in != 9 || in_sizes[0] != M * DM || out_size != M * DM || ws_size < WS_END) { fprintf(stderr, "kernel_launch: unexpected shapes (n_in %d, in0 %d, out %d, ws %zu)\n", n_in, n_in > 0 ? in_sizes[0] : -1, out_size, ws_size); grid = -1; return; }
        int dev = 0, cus = 0, per_cu = 0;
        (void)hipGetDevice(&dev); (void)hipDeviceGetAttribute(&cus, hipDeviceAttributeMultiprocessorCount, dev);
        if (hipFuncSetAttribute((const void*)hybrid_fwd, hipFuncAttributeMaxDynamicSharedMemorySize, LDS_BYTES) != hipSuccess) { fprintf(stderr, "kernel_launch: hipFuncSetAttribute failed\n"); grid = -1; return; }
        if (hipOccupancyMaxActiveBlocksPerMultiprocessor(&per_cu, (const void*)hybrid_fwd, NWAVES * 64, LDS_BYTES) != hipSuccess || per_cu < 1) { fprintf(stderr, "kernel_launch: occupancy query says %d\n", per_cu); per_cu = 1; }
        (void)hipGetLastError();
        grid = cus * per_cu;
    }
    if (grid < 0) return;
    if (hipMemsetAsync((char*)d_ws + WS_SS, 0, CTL_ZERO_BYTES, stream) != hipSuccess) { fprintf(stderr, "kernel_launch: hipMemsetAsync failed\n"); return; }
    Args a{};
    for (int i = 0; i < 9; ++i) a.in[i] = (const float*)d_in[i];
    a.out = (float*)d_out; a.ws = (unsigned char*)d_ws;
#if MK_N_LAUNCHES == 1
    a.ph_lo = 0; a.ph_hi = NPHASE;
    void* kargs[] = {&a};
    const hipError_t le = hipLaunchCooperativeKernel((const void*)hybrid_fwd, dim3(grid), dim3(NWAVES * 64), kargs, LDS_BYTES, stream);
    if (le != hipSuccess) fprintf(stderr, "kernel_launch: cooperative launch failed: %s (grid %d)\n", hipGetErrorString(le), grid);
#else
    for (int p = 0; p < NPHASE; ++p) { a.ph_lo = p; a.ph_hi = p + 1; hipLaunchKernelGGL(hybrid_fwd, dim3(grid), dim3(NWAVES * 64), LDS_BYTES, stream, a); }
#endif
}
```
